# Optimizing an MI355X kernel written in HIP

```python
import math
import jax
import jax.numpy as jnp
from jax import lax
import numpy as np

D_MODEL = 2048
BATCH = 1
SEQ = 8192
DEPTH = 2

GRID_W = 64
CTX_LEN = 256
N_MOD = 9
D_FF = 5632
NORM_EPS = 1e-6

GLA_WIDTH = D_MODEL // 2
GLA_HEADS = 4
GLA_DK = GLA_WIDTH // (2 * GLA_HEADS)
GLA_DV = GLA_WIDTH // GLA_HEADS
GLA_QK = GLA_HEADS * GLA_DK
GLA_GATE_RANK = 16
GLA_TAU = 16.0
GLA_CHUNK = 64

POOL_WIDTH = D_MODEL - GLA_WIDTH
POOL_WINDOWS = (2, 4, 8, 16)
POOL_GROUPS = 4
POOL_GC = POOL_WIDTH // POOL_GROUPS

IN0_COLS = 2 * GLA_QK + 2 * GLA_WIDTH + 2 * GLA_GATE_RANK + POOL_WIDTH
SPLIT0 = (GLA_QK,
          2 * GLA_QK,
          2 * GLA_QK + GLA_WIDTH,
          2 * GLA_QK + 2 * GLA_WIDTH,
          2 * GLA_QK + 2 * GLA_WIDTH + GLA_GATE_RANK,
          2 * GLA_QK + 2 * GLA_WIDTH + 2 * GLA_GATE_RANK)

DIFF_HEADS = 8
DIFF_DH = D_MODEL // (2 * DIFF_HEADS)
DIFF_DV = 2 * DIFF_DH
Q_BLOCK = 128
ROPE_THETA = 10000.0

N_EVEN = (DEPTH + 1) // 2
N_ODD = DEPTH // 2

kernel_name = "hybrid_gla_pool_diffattn_dit"


def _rms_norm(x):
    x32 = x.astype(jnp.float32)
    y = x32 * lax.rsqrt(jnp.mean(x32 * x32, axis=-1, keepdims=True) + NORM_EPS)
    return y.astype(x.dtype)


def _modulate(x, shift, scale):
    return x * (1 + scale) + shift


def _swiglu(z, w1, w3, w2):
    return (jax.nn.silu(z @ w1) * (z @ w3)) @ w2


def _ffn_half(h, m, slot, w1, w3, w2):
    z = _modulate(_rms_norm(h), m[:, :, 3 * slot], m[:, :, 3 * slot + 1])
    return h + 0.5 * m[:, :, 3 * slot + 2] * _swiglu(z, w1, w3, w2)


def _gla_scan(q, k, v, g, s0):
    f32 = jnp.float32
    B, L, H, _ = q.shape
    n = L // GLA_CHUNK

    def to_chunks(a):
        return jnp.moveaxis(a.astype(f32).reshape(B, n, GLA_CHUNK, H, a.shape[-1]), 1, 0)

    qc, kc, vc, gc = to_chunks(q), to_chunks(k), to_chunks(v), to_chunks(g)
    causal = jnp.tril(jnp.ones((GLA_CHUNK, GLA_CHUNK), bool))[None, :, :, None, None]

    def step(S, inp):
        qb, kb, vb, gb = inp
        b = jnp.cumsum(gb, axis=1)
        inter = jnp.einsum('bthk,bhkv->bthv', qb * jnp.exp(b), S)
        diff = b[:, :, None] - b[:, None, :]
        decay = jnp.exp(jnp.where(causal, diff, -jnp.inf))
        attn = jnp.einsum('bthk,bshk,btshk->bhts', qb, kb, decay)
        intra = jnp.einsum('bhts,bshv->bthv', attn, vb)
        b_last = b[:, -1]
        S_new = jnp.exp(b_last)[..., None] * S + jnp.einsum(
            'bshk,bshv->bhkv', kb * jnp.exp(b_last[:, None] - b), vb)
        return S_new, inter + intra

    S_fin, out = lax.scan(step, s0, (qc, kc, vc, gc))
    out = jnp.moveaxis(out, 0, 1).reshape(B, L, H, v.shape[-1])
    return out, S_fin


def _gla_direction(ctx_in, lat_in, reverse):
    if reverse:
        ctx_in = tuple(jnp.flip(a, axis=1) for a in ctx_in)
        lat_in = tuple(jnp.flip(a, axis=1) for a in lat_in)
    B = lat_in[0].shape[0]
    s0 = jnp.zeros((B, GLA_HEADS, GLA_DK, GLA_DV), jnp.float32)
    o_ctx, s_ctx = _gla_scan(*ctx_in, s0)
    o_lat, _ = _gla_scan(*lat_in, s_ctx)
    if reverse:
        o_ctx = jnp.flip(o_ctx, axis=1)
        o_lat = jnp.flip(o_lat, axis=1)
    return o_ctx, o_lat


def _multiscale_pool(u):
    B, L, _ = u.shape
    u32 = u.astype(jnp.float32)
    cs = jnp.concatenate([jnp.zeros((B, 1, POOL_WIDTH), jnp.float32), jnp.cumsum(u32, axis=1)], axis=1)
    t = jnp.arange(L)
    outs = []
    for gi, w in enumerate(POOL_WINDOWS):
        lo = jnp.clip(t - w // 2, 0, L)
        hi = jnp.clip(t + (w - w // 2), 0, L)
        sl = slice(gi * POOL_GC, (gi + 1) * POOL_GC)
        s = cs[:, hi, sl] - cs[:, lo, sl]
        cnt = (hi - lo).astype(jnp.float32)[None, :, None]
        outs.append(s / cnt - u32[..., sl])
    return jnp.stack(outs, axis=2)


def _mixer_even(a, ac, w_in, gate_w2, gate_b, norm_w, pool_w, pool_scale, w_out, need_ctx):
    def project(z):
        B, L, _ = z.shape
        q, k, v, r, gf, gb, u = jnp.split(z @ w_in, SPLIT0, axis=-1)
        q = q.reshape(B, L, GLA_HEADS, GLA_DK) * (GLA_DK ** -0.5)
        k = k.reshape(B, L, GLA_HEADS, GLA_DK)
        v = v.reshape(B, L, GLA_HEADS, GLA_DV)

        def log_gate(gz, d):
            zz = (gz @ gate_w2[d] + gate_b[d]).astype(jnp.float32)
            return (jax.nn.log_sigmoid(zz) / GLA_TAU).reshape(B, L, GLA_HEADS, GLA_DK)

        return q, k, v, r, log_gate(gf, 0), log_gate(gb, 1), u

    q, k, v, r, lf, lb, u = project(a)
    qc, kc, vc, rc, lfc, lbc, uc = project(ac)
    ocf, olf = _gla_direction((qc, kc, vc, lfc), (q, k, v, lf), reverse=False)
    ocb, olb = _gla_direction((qc, kc, vc, lbc), (q, k, v, lb), reverse=True)

    def readout(o, r, u):
        B, L = o.shape[:2]
        o = _rms_norm(o) * norm_w
        g = o.astype(r.dtype).reshape(B, L, GLA_WIDTH) * jax.nn.silu(r)
        pooled = _multiscale_pool(u).astype(u.dtype)
        p = jnp.einsum('blgc,gcd->blgd', pooled, pool_w).reshape(B, L, POOL_WIDTH) * pool_scale
        return jnp.concatenate([g, p], axis=-1) @ w_out

    y = readout(olf + olb, r, u)
    yc = readout(ocf + ocb, rc, uc) if need_ctx else None
    return y, yc


def _axial_rope_tables(L):
    rows = L // GRID_W
    row = jnp.repeat(jnp.arange(rows), GRID_W).astype(jnp.float32)
    col = jnp.tile(jnp.arange(GRID_W), rows).astype(jnp.float32)
    n_freq = DIFF_DH // 4
    inv_freq = ROPE_THETA ** (-jnp.arange(n_freq, dtype=jnp.float32) / n_freq)
    ang = jnp.concatenate([row[:, None] * inv_freq, col[:, None] * inv_freq], axis=-1)
    return jnp.cos(ang), jnp.sin(ang)


def _rope(x, cos, sin):
    half = x.shape[-1] // 2
    x1, x2 = x[..., :half], x[..., half:]
    c = cos[None, :, None, None, :].astype(x.dtype)
    s = sin[None, :, None, None, :].astype(x.dtype)
    return jnp.concatenate([x1 * c - x2 * s, x1 * s + x2 * c], axis=-1)


def _mixer_odd(a, ac, w_qkv, lam_p, norm_w, w_out, lam_init, need_ctx):
    B, L, _ = a.shape
    scale = DIFF_DH ** -0.5
    lp = lam_p.astype(jnp.float32)
    lam = jnp.exp(jnp.sum(lp[0] * lp[1])) - jnp.exp(jnp.sum(lp[2] * lp[3])) + lam_init

    def project(z):
        Bz, Lz, _ = z.shape
        q, k, v = jnp.split(z @ w_qkv, 3, axis=-1)
        return (q.reshape(Bz, Lz, DIFF_HEADS, 2, DIFF_DH),
                k.reshape(Bz, Lz, DIFF_HEADS, 2, DIFF_DH),
                v.reshape(Bz, Lz, DIFF_HEADS, DIFF_DV))

    q, k, v = project(a)
    qc, kc, vc = project(ac)
    cos, sin = _axial_rope_tables(L)
    q = _rope(q, cos, sin)
    k = _rope(k, cos, sin)
    k_all = jnp.concatenate([kc, k], axis=1)
    v_all = jnp.concatenate([vc, v], axis=1)

    def attend(qb, keys, vals):
        s = jnp.einsum('bqhcd,bkhcd->bchqk', qb, keys).astype(jnp.float32) * scale
        p = jax.nn.softmax(s, axis=-1)
        w = p[:, 0] - lam * p[:, 1]
        return jnp.einsum('bhqk,bkhv->bqhv', w.astype(vals.dtype), vals)

    nb = L // Q_BLOCK
    qblocks = jnp.moveaxis(q.reshape(B, nb, Q_BLOCK, DIFF_HEADS, 2, DIFF_DH), 1, 0)
    o = lax.map(lambda qb: attend(qb, k_all, v_all), qblocks)
    o = jnp.moveaxis(o, 0, 1).reshape(B, L, DIFF_HEADS, DIFF_DV)

    def readout(o):
        o = _rms_norm(o) * norm_w * (1.0 - lam_init)
        return o.reshape(o.shape[0], o.shape[1], D_MODEL) @ w_out

    y = readout(o)
    yc = readout(attend(qc, kc, vc)) if need_ctx else None
    return y, yc


def setup_inputs(seed: int = 0) -> dict:
    key = jax.random.key(seed)
    ks = jax.random.split(key, 24)
    f32 = jnp.float32
    D = D_MODEL

    def nrm(k, shape, std):
        return jax.random.normal(k, shape, f32) * std

    return {
        "x": nrm(ks[0], (BATCH, SEQ, D), 1.0),
        "c": nrm(ks[1], (BATCH, D), 1.0),
        "ctx": nrm(ks[2], (BATCH, CTX_LEN, D), 1.0),
        "c_ctx": nrm(ks[3], (D,), 1.0),
        "ada_w": nrm(ks[4], (DEPTH, D, N_MOD * D), 0.5 * D ** -0.5),
        "ada_b": nrm(ks[5], (DEPTH, N_MOD * D), 0.02),
        "ffn_w1": nrm(ks[6], (DEPTH, 2, D, D_FF), D ** -0.5),
        "ffn_w3": nrm(ks[7], (DEPTH, 2, D, D_FF), D ** -0.5),
        "ffn_w2": nrm(ks[8], (DEPTH, 2, D_FF, D), D_FF ** -0.5),
        "gla_w_in": nrm(ks[9], (N_EVEN, D, IN0_COLS), D ** -0.5),
        "gla_gate_w2": nrm(ks[10], (N_EVEN, 2, GLA_GATE_RANK, GLA_QK), GLA_GATE_RANK ** -0.5),
        "gla_gate_b": nrm(ks[11], (N_EVEN, 2, GLA_QK), 0.1),
        "gla_norm_w": 1.0 + nrm(ks[12], (N_EVEN, GLA_DV), 0.1),
        "pool_w": nrm(ks[13], (N_EVEN, POOL_GROUPS, POOL_GC, POOL_GC), POOL_GC ** -0.5),
        "pool_scale": 1.0 + nrm(ks[14], (N_EVEN, POOL_WIDTH), 0.1),
        "mix0_w_out": nrm(ks[15], (N_EVEN, D, D), D ** -0.5),
        "diff_w_qkv": nrm(ks[16], (N_ODD, D, 3 * D), D ** -0.5),
        "diff_lambda": nrm(ks[17], (N_ODD, 4, DIFF_DH), 0.1),
        "diff_norm_w": 1.0 + nrm(ks[18], (N_ODD, DIFF_DV), 0.1),
        "diff_w_out": nrm(ks[19], (N_ODD, D, D), D ** -0.5),
        "final_norm_w": 1.0 + nrm(ks[20], (D,), 0.1),
    }


def reference(x, c, ctx, c_ctx, ada_w, ada_b, ffn_w1, ffn_w3, ffn_w2,
              gla_w_in, gla_gate_w2, gla_gate_b, gla_norm_w, pool_w, pool_scale, mix0_w_out,
              diff_w_qkv, diff_lambda, diff_norm_w, diff_w_out, final_norm_w):
    h, hc = x, ctx
    B = x.shape[0]
    for i in range(DEPTH):
        last = i == DEPTH - 1
        m = (jax.nn.silu(c) @ ada_w[i] + ada_b[i]).reshape(B, 1, N_MOD, D_MODEL)
        mc = (jax.nn.silu(c_ctx) @ ada_w[i] + ada_b[i]).reshape(1, 1, N_MOD, D_MODEL)
        h = _ffn_half(h, m, 0, ffn_w1[i, 0], ffn_w3[i, 0], ffn_w2[i, 0])
        hc = _ffn_half(hc, mc, 0, ffn_w1[i, 0], ffn_w3[i, 0], ffn_w2[i, 0])
        a = _modulate(_rms_norm(h), m[:, :, 3], m[:, :, 4])
        ac = _modulate(_rms_norm(hc), mc[:, :, 3], mc[:, :, 4])
        j = i // 2
        if i % 2 == 0:
            y, yc = _mixer_even(a, ac, gla_w_in[j], gla_gate_w2[j], gla_gate_b[j], gla_norm_w[j],
                                pool_w[j], pool_scale[j], mix0_w_out[j], not last)
        else:
            lam_init = 0.8 - 0.6 * math.exp(-0.3 * i)
            y, yc = _mixer_odd(a, ac, diff_w_qkv[j], diff_lambda[j], diff_norm_w[j], diff_w_out[j],
                               lam_init, not last)
        h = h + m[:, :, 5] * y
        h = _ffn_half(h, m, 2, ffn_w1[i, 1], ffn_w3[i, 1], ffn_w2[i, 1])
        if not last:
            hc = hc + mc[:, :, 5] * yc
            hc = _ffn_half(hc, mc, 2, ffn_w1[i, 1], ffn_w3[i, 1], ffn_w2[i, 1])
    return _rms_norm(h) * final_norm_w
```

```cpp
#include <hip/hip_runtime.h>
#include <hip/hip_bf16.h>
#include <hip/hip_cooperative_groups.h>
#include <cstdio>
#include <cstdint>
#include <cmath>
namespace pg8 {
#define PG8_LAS __attribute__((address_space(3)))
typedef unsigned short bf16_t;
typedef short bf16x8 __attribute__((ext_vector_type(8)));
typedef float f32x4 __attribute__((ext_vector_type(4)));
typedef unsigned u32x4 __attribute__((ext_vector_type(4)));
constexpr int BM = 256, BK = 64, HALF = 128, HTB = HALF * BK * 2  , STAGE_BYTES = 8 * HTB, NXCD = 8, WGM = 8;

__host__ __device__ __forceinline__ int lds_byte(int r, int c) { const int st = (r >> 4) * 2 + (c >> 5), rr = r & 15, cc = c & 31, ob = rr * 64 + cc * 2; return st * 1024 + (ob ^ (((ob >> 9) & 1) << 5)); }
__host__ __device__ __forceinline__ void stage_rc(int b, int& R, int& C) { const int st = b / 1024, sb = b % 1024, swz = sb ^ (((sb >> 9) & 1) << 5); R = (st >> 1) * 16 + swz / 64; C = (st & 1) * 32 + (swz % 64) / 2; }
__host__ __device__ __forceinline__ int perm32(int rho) { const int n = rho >> 4, i = rho & 15; return 8 * (i >> 2) + 4 * n + (i & 3); }

struct Unit { int pm, pn, kt0, nkt; };
struct Gemm { const bf16_t* A; const bf16_t* Bt; int M, N, K; };

struct StaticOrder {
    int nM, nN, nwg, G, c, nkt_full, grp;
    __host__ __device__ void init(int M, int N, int G_, int c_, int K_, int grp_ = 0) { nM = M / BM; nN = N / BM; nwg = nM * nN; G = G_; c = c_; nkt_full = K_ / BK; grp = grp_; }
    __host__ __device__ bool next(int i, Unit& u) const {
        const long L = (long)i * G + c; if (L >= nwg) return false;
        int wgid = (int)L; { const int q = nwg / NXCD, r = nwg % NXCD, xcd = wgid % NXCD, off = wgid / NXCD; wgid = (xcd < r ? xcd * (q + 1) : r * (q + 1) + (xcd - r) * q) + off; }
        const int nig = WGM * nN, gid = wgid / nig, fm = gid * WGM, gsz = (nM - fm) < WGM ? (nM - fm) : WGM;
        u.pm = fm + ((wgid % nig) % gsz); u.pn = (wgid % nig) / gsz; u.kt0 = 0; u.nkt = nkt_full; if (grp) u.pn = u.pm / grp; return true;
    }
    __device__ __forceinline__ void a_ready(const Unit&) const {}
    __device__ __forceinline__ void done(const Unit&) const {}
};

__device__ __forceinline__ unsigned cvt_pk_bf16(float lo, float hi) { unsigned r; asm volatile("v_cvt_pk_bf16_f32 %0, %1, %2" : "=v"(r) : "v"(lo), "v"(hi)); return r; }
typedef float f32x2 __attribute__((ext_vector_type(2)));
__device__ __forceinline__ f32x2 gelu_pk(f32x2 v) {
    const f32x2 av = __builtin_elementwise_abs(v), d = av * 0.2316418882f + 1.0f;
    f32x2 t; t.x = __builtin_amdgcn_rcpf(d.x); t.y = __builtin_amdgcn_rcpf(d.y);
    f32x2 q = t * 0.5307027145f + (-0.7265760135f); q = q * t + 0.7107068705f; q = q * t + (-0.142248368f); q = q * t + 0.127414796f; q = q * t;
    const f32x2 s = (v * v) * (-0.72134752044f);
    f32x2 e; e.x = __builtin_amdgcn_exp2f(s.x); e.y = __builtin_amdgcn_exp2f(s.y);
    const f32x2 m = v * (q * e), r = v - m;
    f32x2 o; o.x = v.x < 0.f ? m.x : r.x; o.y = v.y < 0.f ? m.y : r.y; return o;
}

template <int ACT  > struct EpiBf16 {
    static constexpr bool PERM = true, AFTER_DRAIN = false; static_assert(ACT == 0 || ACT == 1, "EpiBf16: ACT is 0 (none) or 1 (gelu_pk)");
    bf16_t* O; int ldc; const float* bias; int split_cols; size_t split_stride; float scale0;
    __device__ __forceinline__ void operator()(const f32x4 (&acc)[2][2][4][2], const Unit& u, int wr, int wc, int fr, int fq) const {
        const int row0 = u.pm * BM + wr * 64 + fr; int colt = u.pn * BM; bf16_t* base = O;
        float sc = 1.f; if (split_cols) { const int t = colt / split_cols; base += (size_t)t * split_stride; colt -= t * split_cols; if (t == 0) sc = scale0; }
        const int col0 = colt + wc * 32 + 8 * fq, bcol0 = u.pn * BM + wc * 32 + 8 * fq;
        f32x4 bv[2][2];
#pragma unroll
        for (int bj = 0; bj < 2; ++bj)
#pragma unroll
            for (int n = 0; n < 2; ++n) bv[bj][n] = bias ? *(const f32x4*)(bias + bcol0 + bj * HALF + 4 * n) : (f32x4){0.f, 0.f, 0.f, 0.f};
#pragma unroll
        for (int ai = 0; ai < 2; ++ai)
#pragma unroll
            for (int m = 0; m < 4; ++m) { bf16_t* rowp = base + (size_t)(row0 + ai * HALF + m * 16) * ldc + col0;
#pragma unroll
                for (int bj = 0; bj < 2; ++bj) { f32x4 v0 = acc[ai][bj][m][0] + bv[bj][0], v1 = acc[ai][bj][m][1] + bv[bj][1];
                    if (ACT == 1) { f32x2 a = gelu_pk((f32x2){v0[0], v0[1]}), b = gelu_pk((f32x2){v0[2], v0[3]}), c = gelu_pk((f32x2){v1[0], v1[1]}), d = gelu_pk((f32x2){v1[2], v1[3]});
                        v0 = (f32x4){a.x, a.y, b.x, b.y}; v1 = (f32x4){c.x, c.y, d.x, d.y}; }
                    v0 = v0 * sc; v1 = v1 * sc; u32x4 w; w.x = cvt_pk_bf16(v0[0], v0[1]); w.y = cvt_pk_bf16(v0[2], v0[3]); w.z = cvt_pk_bf16(v1[0], v1[1]); w.w = cvt_pk_bf16(v1[2], v1[3]);
                    *(u32x4*)(rowp + bj * HALF) = w; } }
    }
};

__device__ __forceinline__ float silu_f(float x) { return x * __builtin_amdgcn_rcpf(1.0f + __expf(-x)); }
struct EpiSwiglu {
    static constexpr bool PERM = true, AFTER_DRAIN = false;
    bf16_t* U; int ldc;
    __device__ __forceinline__ void operator()(const f32x4 (&acc)[2][2][4][2], const Unit& u, int wr, int wc, int fr, int fq) const {
        const int row0 = u.pm * BM + wr * 64 + fr; const int col0 = u.pn * HALF + wc * 32 + 8 * fq;
#pragma unroll
        for (int ai = 0; ai < 2; ++ai)
#pragma unroll
            for (int m = 0; m < 4; ++m) { bf16_t* rowp = U + (size_t)(row0 + ai * HALF + m * 16) * ldc + col0;
                const f32x4 a0 = acc[ai][0][m][0], a1 = acc[ai][0][m][1], b0 = acc[ai][1][m][0], b1 = acc[ai][1][m][1];
                f32x4 v0, v1;
#pragma unroll
                for (int i = 0; i < 4; ++i) { v0[i] = silu_f(a0[i]) * b0[i]; v1[i] = silu_f(a1[i]) * b1[i]; }
                u32x4 w; w.x = cvt_pk_bf16(v0[0], v0[1]); w.y = cvt_pk_bf16(v0[2], v0[3]); w.z = cvt_pk_bf16(v1[0], v1[1]); w.w = cvt_pk_bf16(v1[2], v1[3]);
                *(u32x4*)rowp = w; }
    }
};
struct ResidOrder {
    StaticOrder base; int c, nsplit, split;
    __device__ void init(int M, int N, int K, int G_, int c_) { split = (G_ == 256 && M == 8448 && N == 2048) ? 1 : 0; base.init(split ? 8192 : M, N, G_, c_, K); c = c_; nsplit = (K / BK) / 8; }
    __device__ bool next(int i, Unit& u) const {
        if (!split) return base.next(i, u);
        if (i == 0) return base.next(0, u);
        if (i == 1 && c < 8 * nsplit) { u.pm = 32; u.pn = c & 7; u.nkt = 8; u.kt0 = (c >> 3) * 8; return true; }
        return false;
    }
    __device__ __forceinline__ void a_ready(const Unit&) const {}
    __device__ __forceinline__ void done(const Unit&) const {}
};
struct EpiResid {
    static constexpr bool PERM = false, AFTER_DRAIN = false;
    float* H; const float* Hin; const float* gate_lat; const float* gate_ctx; float coef; int ldc; int ctx_atomic; float* PART;
    __device__ __forceinline__ void operator()(const f32x4 (&acc)[2][2][4][2], const Unit& u, int wr, int wc, int fr, int fq) const {
        const float* gate = (u.pm >= 32) ? gate_ctx : gate_lat;
        const int row0 = u.pm * BM + wr * 64 + fr; const int col0 = u.pn * BM + wc * 32 + 4 * fq;
        f32x4 gv[2][2];
#pragma unroll
        for (int bj = 0; bj < 2; ++bj)
#pragma unroll
            for (int n = 0; n < 2; ++n) gv[bj][n] = *(const f32x4*)(gate + col0 + bj * HALF + n * 16) * coef;
        if (ctx_atomic && u.pm >= 32) {
            float* Pb = PART + ((size_t)(u.kt0 >> 3) * 256 + (size_t)(wr * 64 + fr)) * 2048 + col0;
#pragma unroll
            for (int ai = 0; ai < 2; ++ai)
#pragma unroll
                for (int m = 0; m < 4; ++m) { float* rowp = Pb + (size_t)(ai * HALF + m * 16) * 2048;
#pragma unroll
                    for (int bj = 0; bj < 2; ++bj)
#pragma unroll
                        for (int n = 0; n < 2; ++n) *(f32x4*)(rowp + bj * HALF + n * 16) = gv[bj][n] * acc[ai][bj][m][n]; }
        } else {
#pragma unroll
            for (int ai = 0; ai < 2; ++ai)
#pragma unroll
                for (int mp = 0; mp < 2; ++mp) {
                    f32x4 hv[2][2][2];
#pragma unroll
                    for (int m2 = 0; m2 < 2; ++m2)
#pragma unroll
                        for (int bj = 0; bj < 2; ++bj)
#pragma unroll
                            for (int n = 0; n < 2; ++n) hv[m2][bj][n] = *(const f32x4*)(Hin + (size_t)(row0 + ai * HALF + (2 * mp + m2) * 16) * ldc + col0 + bj * HALF + n * 16);
#pragma unroll
                    for (int m2 = 0; m2 < 2; ++m2)
#pragma unroll
                        for (int bj = 0; bj < 2; ++bj)
#pragma unroll
                            for (int n = 0; n < 2; ++n) *(f32x4*)(H + (size_t)(row0 + ai * HALF + (2 * mp + m2) * 16) * ldc + col0 + bj * HALF + n * 16) = hv[m2][bj][n] + gv[bj][n] * acc[ai][bj][2 * mp + m2][n];
                    asm volatile("" ::: "memory");
                }
        }
    }
};
struct EpiStore {
    static constexpr bool PERM = true, AFTER_DRAIN = false;
    bf16_t* O; int ldc; const float* scale; int grp;
    __device__ __forceinline__ void operator()(const f32x4 (&acc)[2][2][4][2], const Unit& u, int wr, int wc, int fr, int fq) const {
        const int row0 = (grp ? u.pm - u.pn * grp : u.pm) * BM + wr * 64 + fr; const int col0 = u.pn * BM + wc * 32 + 8 * fq;
        f32x4 sv[2][2];
#pragma unroll
        for (int bj = 0; bj < 2; ++bj)
#pragma unroll
            for (int n = 0; n < 2; ++n) sv[bj][n] = scale ? *(const f32x4*)(scale + col0 + bj * HALF + 4 * n) : (f32x4){1.f, 1.f, 1.f, 1.f};
#pragma unroll
        for (int ai = 0; ai < 2; ++ai)
#pragma unroll
            for (int m = 0; m < 4; ++m) { bf16_t* rowp = O + (size_t)(row0 + ai * HALF + m * 16) * ldc + col0;
#pragma unroll
                for (int bj = 0; bj < 2; ++bj) { const f32x4 v0 = acc[ai][bj][m][0] * sv[bj][0], v1 = acc[ai][bj][m][1] * sv[bj][1];
                    u32x4 w; w.x = cvt_pk_bf16(v0[0], v0[1]); w.y = cvt_pk_bf16(v0[2], v0[3]); w.z = cvt_pk_bf16(v1[0], v1[1]); w.w = cvt_pk_bf16(v1[2], v1[3]);
                    *(u32x4*)(rowp + bj * HALF) = w; } }
    }
};
struct EpiQkv {
    static constexpr bool PERM = true, AFTER_DRAIN = false;
    bf16_t* O; int ldc; const float* rc; const float* rs;
    __device__ __forceinline__ void operator()(const f32x4 (&acc)[2][2][4][2], const Unit& u, int wr, int wc, int fr, int fq) const {
        typedef unsigned u32x2v __attribute__((ext_vector_type(2)));
        const int row0 = u.pm * BM + wr * 64 + fr;
        if (u.pn >= 16) {
            const int col0 = u.pn * BM + wc * 32 + 8 * fq;
#pragma unroll
            for (int ai = 0; ai < 2; ++ai)
#pragma unroll
                for (int m = 0; m < 4; ++m) { bf16_t* rowp = O + (size_t)(row0 + ai * HALF + m * 16) * ldc + col0;
#pragma unroll
                    for (int bj = 0; bj < 2; ++bj) { const f32x4 v0 = acc[ai][bj][m][0], v1 = acc[ai][bj][m][1];
                        u32x4 w; w.x = cvt_pk_bf16(v0[0], v0[1]); w.y = cvt_pk_bf16(v0[2], v0[3]); w.z = cvt_pk_bf16(v1[0], v1[1]); w.w = cvt_pk_bf16(v1[2], v1[3]);
                        *(u32x4*)(rowp + bj * HALF) = w; } }
        } else {
            const int q4 = 4 * (4 * wc + fq);
            const bool rot = u.pm < 32;
#pragma unroll
            for (int ai = 0; ai < 2; ++ai)
#pragma unroll
                for (int m = 0; m < 4; ++m) { const int row = row0 + ai * HALF + m * 16;
                    f32x4 c = (f32x4){1.f, 1.f, 1.f, 1.f}, s = (f32x4){0.f, 0.f, 0.f, 0.f};
                    if (rot) { c = *(const f32x4*)(rc + (size_t)row * 64 + q4); s = *(const f32x4*)(rs + (size_t)row * 64 + q4); }
                    bf16_t* rowp = O + (size_t)row * ldc + u.pn * BM + q4;
#pragma unroll
                    for (int bj = 0; bj < 2; ++bj) { const f32x4 x1 = acc[ai][bj][m][0], x2 = acc[ai][bj][m][1];
                        const f32x4 o1 = x1 * c - x2 * s, o2 = x1 * s + x2 * c;
                        u32x2v w1, w2; w1.x = cvt_pk_bf16(o1[0], o1[1]); w1.y = cvt_pk_bf16(o1[2], o1[3]); w2.x = cvt_pk_bf16(o2[0], o2[1]); w2.y = cvt_pk_bf16(o2[2], o2[3]);
                        *(u32x2v*)(rowp + bj * HALF) = w1; *(u32x2v*)(rowp + bj * HALF + 64) = w2; } }
        }
    }
};
template <class Epi, class Sched, bool ALIGN_EPI = false, bool SP2 = false>
__device__ __forceinline__ void gemm_phase(PG8_LAS unsigned char* lds, const Gemm g, const Sched& S, const Epi& E, int tid_in) {
    int tid_l = tid_in; asm volatile("" : "+v"(tid_l)); const int tid = tid_l, wid = __builtin_amdgcn_readfirstlane(tid >> 6), lane = tid & 63, wr = wid >> 2, wc = wid & 3, fr = lane & 15, fq = lane >> 4;
    const int K = g.K; int nt = K / BK;
    unsigned voffA[2], voffB[2];
#pragma unroll
    for (int i = 0; i < 2; ++i) { int R, C; stage_rc(tid * 16 + i * 8192, R, C); const int Rb = Epi::PERM ? ((R & ~31) + perm32(R & 31)) : R;
        voffA[i] = (unsigned)(R * K + C) * 2u; voffB[i] = (unsigned)(Rb * K + C) * 2u; }
    const size_t kstep = (size_t)(BK * 2);
    const size_t hstep = (size_t)HALF * K * 2;
    const size_t tstep = 2 * hstep;
    const unsigned ldsw = (unsigned)wid * 1024u;
    const int aoff = lds_byte(wr * 64 + fr, fq * 8), boff = lds_byte(wc * 32 + fr, fq * 8);
#define PG8_SA(b, h) (((b) * 2 + (h)) * HTB)
#define PG8_SB(b, h) ((4 + (b) * 2 + (h)) * HTB)
#define PG8_STAGE(bufoff, gbase, voff) do { _Pragma("unroll") for (int _i = 0; _i < 2; ++_i) \
        __builtin_amdgcn_global_load_lds((const unsigned*)((const char*)(gbase) + (voff)[_i]), (PG8_LAS unsigned*)(lds + (bufoff) + ldsw + _i * 8192), 16, 0, 0); } while (0)
#define PG8_LDA(dst, b, h) do { _Pragma("unroll") for (int m = 0; m < 4; ++m) _Pragma("unroll") for (int k = 0; k < 2; ++k) dst[m][k] = *(const PG8_LAS bf16x8*)(lds + PG8_SA(b, h) + aoff + m * 2048 + k * 1024); } while (0)
#define PG8_LDB(dst, b, h) do { _Pragma("unroll") for (int n = 0; n < 2; ++n) _Pragma("unroll") for (int k = 0; k < 2; ++k) dst[n][k] = *(const PG8_LAS bf16x8*)(lds + PG8_SB(b, h) + boff + n * 2048 + k * 1024); } while (0)
#define PG8_MMA(ai, bj, At, Bt) do { __builtin_amdgcn_s_setprio(1); _Pragma("unroll") for (int m = 0; m < 4; ++m) _Pragma("unroll") for (int n = 0; n < 2; ++n) _Pragma("unroll") for (int k = 0; k < 2; ++k) \
        acc[ai][bj][m][n] = __builtin_amdgcn_mfma_f32_16x16x32_bf16(Bt[n][k], At[m][k], acc[ai][bj][m][n], 0, 0, 0); __builtin_amdgcn_s_setprio(0); } while (0)
#define PG8_WAIT_V(n) asm volatile("s_waitcnt vmcnt(" #n ")" ::: "memory")
#define PG8_WAIT_L(n) asm volatile("s_waitcnt lgkmcnt(" #n ")" ::: "memory")
#define PG8_BAR __builtin_amdgcn_s_barrier()
#define PG8_SCHED __builtin_amdgcn_sched_barrier(0)
    Unit cur, nxt; int ui = 0;
    if (!S.next(0, cur)) return;
    f32x4 acc[2][2][4][2];
#pragma unroll
    for (int a = 0; a < 2; ++a)
#pragma unroll
        for (int b = 0; b < 2; ++b)
#pragma unroll
            for (int m = 0; m < 4; ++m)
#pragma unroll
                for (int n = 0; n < 2; ++n) acc[a][b][m][n] = (f32x4){0.f, 0.f, 0.f, 0.f};
    bf16x8 At[4][2], B0[2][2], B1[2][2];
    nt = cur.nkt;
    const char* cA = (const char*)g.A + (size_t)cur.pm * tstep + (size_t)cur.kt0 * (size_t)(BK * 2); const char* cB = (const char*)g.Bt + (size_t)cur.pn * tstep + (size_t)cur.kt0 * (size_t)(BK * 2);
    S.a_ready(cur);
    if constexpr (SP2) {
        PG8_STAGE(PG8_SB(0, 0), cB, voffB); PG8_STAGE(PG8_SB(0, 1), cB + hstep, voffB); PG8_STAGE(PG8_SA(0, 0), cA, voffA); PG8_STAGE(PG8_SA(0, 1), cA + hstep, voffA);
        if (wr == 1) PG8_BAR;
        PG8_WAIT_V(2); PG8_BAR;
        PG8_STAGE(PG8_SB(1, 0), cB + kstep, voffB); PG8_STAGE(PG8_SA(1, 0), cA + kstep, voffA); PG8_STAGE(PG8_SB(1, 1), cB + hstep + kstep, voffB);
        PG8_WAIT_V(6); PG8_BAR;
    } else {
        PG8_STAGE(PG8_SB(0, 0), cB, voffB); PG8_STAGE(PG8_SA(0, 0), cA, voffA); PG8_STAGE(PG8_SB(0, 1), cB + hstep, voffB); PG8_STAGE(PG8_SA(0, 1), cA + hstep, voffA);
        if (wr == 1) PG8_BAR;
        PG8_WAIT_V(4); PG8_BAR;
        PG8_STAGE(PG8_SB(1, 0), cB + kstep, voffB); PG8_STAGE(PG8_SA(1, 0), cA + kstep, voffA); PG8_STAGE(PG8_SB(1, 1), cB + hstep + kstep, voffB);
        PG8_WAIT_V(6); PG8_BAR;
    }
    for (;;) {
        const bool has_next = S.next(ui + 1, nxt);
        const char* nA = has_next ? (const char*)g.A + (size_t)nxt.pm * tstep + (size_t)nxt.kt0 * kstep : cA; const char* nB = has_next ? (const char*)g.Bt + (size_t)nxt.pn * tstep + (size_t)nxt.kt0 * kstep : cB;
        for (int t = 0; t < nt; t += 2) {
            const bool last = (t == nt - 2);
            const char* a1 = cA + (size_t)(t + 1) * kstep;
            const char* a2 = last ? nA : cA + (size_t)(t + 2) * kstep; const char* b2 = last ? nB : cB + (size_t)(t + 2) * kstep;
            const char* a3 = a2 + kstep; const char* b3 = b2 + kstep;
            if (last && has_next) S.a_ready(nxt);
            if constexpr (SP2) {
            PG8_LDB(B0, 0, 0); PG8_LDB(B1, 0, 1); PG8_SCHED; PG8_LDA(At, 0, 0); PG8_STAGE(PG8_SA(1, 1), a1 + hstep, voffA);
            PG8_WAIT_V(8); PG8_WAIT_L(0); PG8_BAR; PG8_MMA(0, 0, At, B0); PG8_MMA(0, 1, At, B1); PG8_BAR; PG8_SCHED;
            PG8_LDA(At, 0, 1); PG8_STAGE(PG8_SB(0, 0), b2, voffB); PG8_STAGE(PG8_SB(0, 1), b2 + hstep, voffB); PG8_STAGE(PG8_SA(0, 0), a2, voffA);
            PG8_WAIT_V(8); PG8_WAIT_L(0); PG8_BAR; PG8_MMA(1, 0, At, B0); PG8_MMA(1, 1, At, B1); PG8_BAR; PG8_SCHED;
            PG8_LDB(B0, 1, 0); PG8_LDB(B1, 1, 1); PG8_SCHED; PG8_LDA(At, 1, 0); PG8_STAGE(PG8_SA(0, 1), a2 + hstep, voffA);
            PG8_WAIT_V(8); PG8_WAIT_L(0); PG8_BAR; PG8_MMA(0, 0, At, B0); PG8_MMA(0, 1, At, B1); PG8_BAR; PG8_SCHED;
            PG8_LDA(At, 1, 1); PG8_STAGE(PG8_SB(1, 0), b3, voffB); PG8_STAGE(PG8_SB(1, 1), b3 + hstep, voffB); PG8_STAGE(PG8_SA(1, 0), a3, voffA);
            PG8_WAIT_V(8); PG8_WAIT_L(0); PG8_BAR; PG8_MMA(1, 0, At, B0); PG8_MMA(1, 1, At, B1); PG8_BAR; PG8_SCHED;
            } else {
            PG8_LDB(B0, 0, 0); PG8_SCHED; PG8_LDA(At, 0, 0); PG8_STAGE(PG8_SA(1, 1), a1 + hstep, voffA);
            PG8_WAIT_L(8); PG8_BAR; PG8_WAIT_L(0); PG8_MMA(0, 0, At, B0); PG8_BAR; PG8_SCHED;
            PG8_LDB(B1, 0, 1); PG8_STAGE(PG8_SB(0, 0), b2, voffB);
            PG8_BAR; PG8_WAIT_L(0); PG8_MMA(0, 1, At, B1); PG8_BAR;
            PG8_LDA(At, 0, 1); PG8_STAGE(PG8_SA(0, 0), a2, voffA);
            PG8_BAR; PG8_WAIT_L(0); PG8_MMA(1, 0, At, B0); PG8_BAR; PG8_SCHED;
            PG8_STAGE(PG8_SB(0, 1), b2 + hstep, voffB);
            PG8_WAIT_V(6); PG8_BAR; PG8_MMA(1, 1, At, B1); PG8_BAR;
            PG8_LDB(B0, 1, 0); PG8_SCHED; PG8_LDA(At, 1, 0); PG8_STAGE(PG8_SA(0, 1), a2 + hstep, voffA);
            PG8_WAIT_L(8); PG8_BAR; PG8_WAIT_L(0); PG8_MMA(0, 0, At, B0); PG8_BAR; PG8_SCHED;
            PG8_LDB(B1, 1, 1); PG8_STAGE(PG8_SB(1, 0), b3, voffB);
            PG8_BAR; PG8_WAIT_L(0); PG8_MMA(0, 1, At, B1); PG8_BAR;
            PG8_LDA(At, 1, 1); PG8_STAGE(PG8_SA(1, 0), a3, voffA);
            PG8_BAR; PG8_WAIT_L(0); PG8_MMA(1, 0, At, B0); PG8_BAR; PG8_SCHED;
            PG8_STAGE(PG8_SB(1, 1), b3 + hstep, voffB);
            PG8_WAIT_V(6); PG8_BAR; PG8_MMA(1, 1, At, B1); PG8_BAR;
            }
        }
        if constexpr (ALIGN_EPI) { if (wr == 0) PG8_BAR; }
        if constexpr (!Epi::AFTER_DRAIN) { E(acc, cur, wr, wc, fr, fq); S.done(cur); }
        if (!has_next) break;
#pragma unroll
        for (int a = 0; a < 2; ++a)
#pragma unroll
            for (int b = 0; b < 2; ++b)
#pragma unroll
                for (int m = 0; m < 4; ++m)
#pragma unroll
                    for (int n = 0; n < 2; ++n) acc[a][b][m][n] = (f32x4){0.f, 0.f, 0.f, 0.f};
        cur = nxt; cA = nA; cB = nB; ++ui; nt = cur.nkt;
        if constexpr (ALIGN_EPI) { if (wr == 1) PG8_BAR; }
    }
    PG8_WAIT_V(0);
    if constexpr (!ALIGN_EPI) { if (wr == 0) PG8_BAR; }
    PG8_BAR;
    if constexpr (Epi::AFTER_DRAIN) { E.fused(acc, cur, wr, wc, fr, fq, lds, wid, lane); S.done(cur); }
#undef PG8_SA
#undef PG8_SB
#undef PG8_STAGE
#undef PG8_LDA
#undef PG8_LDB
#undef PG8_MMA
#undef PG8_WAIT_V
#undef PG8_WAIT_L
#undef PG8_BAR
#undef PG8_SCHED
}
}
namespace att {
using bf16 = __hip_bfloat16;
constexpr int   D = 128, NW = 8, QBLK = 32, KVBLK = 64;
constexpr float SCALE = 0.088388347648318440f;
constexpr float THR = 8.f;
constexpr int SDEPTH = 2;
constexpr int LDQ = 6144, LDK = 6144, LDO = 2048;
constexpr size_t SHM_V = KVBLK * D * 2, SHM_K = KVBLK * D * 2, SHM_ATTN = 2 * SHM_V + 2 * SHM_K + NW * 64 * 4;
using bf16x8 = __attribute__((ext_vector_type(8))) short;
using s16x4  = __attribute__((ext_vector_type(4))) short;
using f32x16 = __attribute__((ext_vector_type(16))) float;
using f32x8  = __attribute__((ext_vector_type(8))) float;
using u32x4  = __attribute__((ext_vector_type(4))) unsigned;
#define KSWZ(row, colB) ((row) * 256 + ((colB) ^ (((row) & 7) << 4)))
#define SBAR() __builtin_amdgcn_sched_barrier(0)
__device__ __forceinline__ int crow(int r, int hi) { return (r & 3) + 8 * (r >> 2) + 4 * hi; }
__device__ __forceinline__ unsigned cvtpk(float lo, float hi) {
  unsigned r; asm volatile("v_cvt_pk_bf16_f32 %0, %1, %2" : "=v"(r) : "v"(lo), "v"(hi)); return r;
}
template <typename TIn> struct Stage;
template <> struct Stage<bf16>  { using T = bf16x8;
  __device__ static __forceinline__ T ld8(const bf16* p) { return *reinterpret_cast<const bf16x8*>(p); }
  __device__ static __forceinline__ bf16x8 tobf(T x) { return x; } };
template <> struct Stage<float> { using T = f32x8;
  __device__ static __forceinline__ T ld8(const float* p) { return *reinterpret_cast<const f32x8*>(p); }
  __device__ static __forceinline__ bf16x8 tobf(T x) {
    u32x4 w = {cvtpk(x[0], x[1]), cvtpk(x[2], x[3]), cvtpk(x[4], x[5]), cvtpk(x[6], x[7])}; return *reinterpret_cast<bf16x8*>(&w); } };

__device__ __forceinline__ void partialSM(f32x16& p0, f32x16& p1, float& m_reg, float& mn, float& alpha) {
  constexpr float C = SCALE * 1.4426950408889634f;
  float pmax = p0[0]; for (int r = 1; r < 16; ++r) pmax = fmaxf(pmax, p0[r]); for (int r = 0; r < 16; ++r) pmax = fmaxf(pmax, p1[r]);
  { auto rr = __builtin_amdgcn_permlane32_swap(__float_as_uint(pmax), __float_as_uint(pmax), false, false);
    pmax = fmaxf(__uint_as_float(rr[0]), __uint_as_float(rr[1])); }
  if (__builtin_expect(__all(pmax - m_reg <= THR / SCALE), 1)) { mn = m_reg; alpha = 1.f; }
  else { mn = fmaxf(m_reg, pmax); alpha = __builtin_amdgcn_exp2f((m_reg - mn) * C); m_reg = mn; }
  float mnC = -mn * C;
  for (int r = 0; r < 16; ++r) p0[r] = fmaf(p0[r], C, mnC); for (int r = 0; r < 16; ++r) p1[r] = fmaf(p1[r], C, mnC);
  for (int r = 0; r < 16; ++r) p0[r] = __builtin_amdgcn_exp2f(p0[r]);
}
__device__ __forceinline__ void finishSM(f32x16& p0, f32x16& p1, float alpha, float& l_reg, bf16x8& pa0, bf16x8& pa1, bf16x8& pa2, bf16x8& pa3) {
  for (int r = 0; r < 16; ++r) p1[r] = __builtin_amdgcn_exp2f(p1[r]);
  float ps = 0; for (int r = 0; r < 16; ++r) ps += p0[r]; for (int r = 0; r < 16; ++r) ps += p1[r];
  { auto rr = __builtin_amdgcn_permlane32_swap(__float_as_uint(ps), __float_as_uint(ps), false, false);
    ps = __uint_as_float(rr[0]) + __uint_as_float(rr[1]); }
  l_reg = l_reg * alpha + ps;
#define PK4(P, BASE, OUT) do { unsigned a0 = cvtpk(P[BASE + 0], P[BASE + 1]), a1 = cvtpk(P[BASE + 2], P[BASE + 3]);   \
    unsigned b0 = cvtpk(P[BASE + 4], P[BASE + 5]), b1 = cvtpk(P[BASE + 6], P[BASE + 7]);                              \
    auto r0 = __builtin_amdgcn_permlane32_swap(a0, b0, false, false); auto r1 = __builtin_amdgcn_permlane32_swap(a1, b1, false, false); \
    u32x4 w = {r0[0], r1[0], r0[1], r1[1]}; OUT = *reinterpret_cast<bf16x8*>(&w); } while (0)
  PK4(p0, 0, pa0); PK4(p0, 8, pa1); PK4(p1, 0, pa2); PK4(p1, 8, pa3);
#undef PK4
}
__device__ __forceinline__ void qkt(f32x16& p0, f32x16& p1, const bf16* Ks, const bf16x8* qr, int r32, int hi) {
  p0 = f32x16{}; p1 = f32x16{};
  for (int d0 = 0; d0 < 8; ++d0) { int cb = (d0 * 16 + hi * 8) * 2;
    bf16x8 b0 = *reinterpret_cast<const bf16x8*>((const char*)Ks + KSWZ(r32, cb));
    bf16x8 b1 = *reinterpret_cast<const bf16x8*>((const char*)Ks + KSWZ(32 + r32, cb));
    p0 = __builtin_amdgcn_mfma_f32_32x32x16_bf16(b0, qr[d0], p0, 0, 0, 0);
    p1 = __builtin_amdgcn_mfma_f32_32x32x16_bf16(b1, qr[d0], p1, 0, 0, 0); }
}
__device__ __forceinline__ int v_st(int k, int c) { const int kk = (k & ~0xC) | ((k & 4) << 1) | ((k & 8) >> 1); return ((kk >> 3) * 4 + (c >> 5)) * 512 + ((kk & 7) * 32 + (c & 31)) * 2; }
__device__ __forceinline__ int v_rd_base(int lane) { return ((lane & 3) << 3) | (((lane >> 2) & 3) << 6) | (((lane >> 4) & 1) << 5) | (((lane >> 5) & 1) << 8); }
constexpr int v_rd_off(int d0, int ks, int half) { return d0 * 512 + ks * 4096 + half * 2048; }
template <int OFF> __device__ __forceinline__ s16x4 tr_read(int vb) {
  s16x4 r; asm volatile("ds_read_b64_tr_b16 %0, %1 offset:%2" : "=&v"(r) : "v"(vb), "i"(OFF) : "memory"); return r;
}
template <int D0> __device__ __forceinline__ void pv_one(f32x16& od, int vb, bf16x8 pa0, bf16x8 pa1, bf16x8 pa2, bf16x8 pa3) {
  const s16x4 l0 = tr_read<v_rd_off(D0, 0, 0)>(vb), h0 = tr_read<v_rd_off(D0, 0, 1)>(vb), l1 = tr_read<v_rd_off(D0, 1, 0)>(vb), h1 = tr_read<v_rd_off(D0, 1, 1)>(vb);
  const s16x4 l2 = tr_read<v_rd_off(D0, 2, 0)>(vb), h2 = tr_read<v_rd_off(D0, 2, 1)>(vb), l3 = tr_read<v_rd_off(D0, 3, 0)>(vb), h3 = tr_read<v_rd_off(D0, 3, 1)>(vb);
  asm volatile("s_waitcnt lgkmcnt(0)" ::: "memory"); SBAR();
#define PK(L, H) (bf16x8){L[0], L[1], L[2], L[3], H[0], H[1], H[2], H[3]}
  od = __builtin_amdgcn_mfma_f32_32x32x16_bf16(pa0, PK(l0, h0), od, 0, 0, 0);
  od = __builtin_amdgcn_mfma_f32_32x32x16_bf16(pa1, PK(l1, h1), od, 0, 0, 0);
  od = __builtin_amdgcn_mfma_f32_32x32x16_bf16(pa2, PK(l2, h2), od, 0, 0, 0);
  od = __builtin_amdgcn_mfma_f32_32x32x16_bf16(pa3, PK(l3, h3), od, 0, 0, 0);
#undef PK
}
__device__ __forceinline__ void pv_d0(f32x16* o, int vb, bf16x8 pa0, bf16x8 pa1, bf16x8 pa2, bf16x8 pa3) {
  pv_one<0>(o[0], vb, pa0, pa1, pa2, pa3); pv_one<1>(o[1], vb, pa0, pa1, pa2, pa3); pv_one<2>(o[2], vb, pa0, pa1, pa2, pa3); pv_one<3>(o[3], vb, pa0, pa1, pa2, pa3);
}

template <typename TQ>
__device__ __forceinline__ void attn_dense_body(const TQ* __restrict__ Qb, const bf16* __restrict__ Kh, const bf16* __restrict__ Vh,
                                                float* __restrict__ Ob, int seq, char* lds, int tid_in) {
  using St = Stage<bf16>; using SQ = Stage<TQ>;
  int tid_l = tid_in; asm volatile("" : "+v"(tid_l)); const int tid = tid_l, wid = tid >> 6, lane = tid & 63, r32 = lane & 31, hi = lane >> 5;
  bf16* V_lds = (bf16*)lds; bf16* K_lds = (bf16*)(lds + 2 * SHM_V);
  float* ws = (float*)(lds + 2 * SHM_V + 2 * SHM_K) + wid * 64; float* li_l = ws; float* al_l = ws + 32;
  float m_reg = -1e30f, l_reg = 0; f32x16 o[4] = {}; bf16x8 qr[8];
  const TQ* Qw = Qb + (long)(wid * QBLK + r32) * LDQ + hi * 8;
#pragma unroll
  for (int d0 = 0; d0 < 8; ++d0) qr[d0] = SQ::tobf(SQ::ld8(Qw + d0 * 16));
  const int sr = tid >> 4, sc = (tid & 15) * 8, vst0 = v_st(sr, sc), vst1 = v_st(32 + sr, sc);
  const int vb0 = (int)(uintptr_t)V_lds + v_rd_base(lane);
  struct { typename St::T vs0, vs1, ks0, ks1; } sr_[SDEPTH];
#define SLOAD(i, k0) do { sr_[i].vs0 = St::ld8(&Vh[(long)((k0) + sr) * LDK + sc]); sr_[i].vs1 = St::ld8(&Vh[(long)((k0) + 32 + sr) * LDK + sc]); \
    sr_[i].ks0 = St::ld8(&Kh[(long)((k0) + sr) * LDK + sc]); sr_[i].ks1 = St::ld8(&Kh[(long)((k0) + 32 + sr) * LDK + sc]); } while (0)
#define SWRITE(b, i) do { *(bf16x8*)((char*)V_lds + (b) * SHM_V + vst0) = St::tobf(sr_[i].vs0);          \
    *(bf16x8*)((char*)V_lds + (b) * SHM_V + vst1) = St::tobf(sr_[i].vs1); int kc = sc * 2;               \
    *(bf16x8*)((char*)K_lds + (b) * SHM_K + KSWZ(sr, kc)) = St::tobf(sr_[i].ks0);                       \
    *(bf16x8*)((char*)K_lds + (b) * SHM_K + KSWZ(32 + sr, kc)) = St::tobf(sr_[i].ks1); } while (0)
#define SWAIT() do { if constexpr (SDEPTH == 2) asm volatile("s_waitcnt vmcnt(4)" ::: "memory"); else asm volatile("s_waitcnt vmcnt(0)" ::: "memory"); } while (0)
#define RESC(a) do { if (__any((a) < 1.f)) { if (hi == 0) al_l[r32] = (a); asm volatile("s_waitcnt lgkmcnt(0)" ::: "memory"); \
    for (int d = 0; d < 4; ++d) for (int r = 0; r < 16; ++r) o[d][r] *= al_l[crow(r, hi)]; } } while (0)
  f32x16 pA0, pA1, pB0, pB1; float mnA, mnB, alA, alB; bf16x8 pa0, pa1, pa2, pa3; const int NT = seq / KVBLK;
  constexpr int SE = 0, SO = SDEPTH - 1;
  SLOAD(SE, 0); asm volatile("s_waitcnt vmcnt(0)" ::: "memory"); SWRITE(0, SE); __syncthreads();
  qkt(pA0, pA1, K_lds, qr, r32, hi); partialSM(pA0, pA1, m_reg, mnA, alA);
  SLOAD(SO, KVBLK); if constexpr (SDEPTH == 2) { if (2 < NT) SLOAD(SE, 2 * KVBLK); }
  SWAIT(); SWRITE(1, SO); __syncthreads();
  for (int j = 1; j + 1 < NT; j += 2) {
    SBAR(); qkt(pB0, pB1, (bf16*)((char*)K_lds + SHM_K), qr, r32, hi);
    finishSM(pA0, pA1, alA, l_reg, pa0, pa1, pa2, pa3); SBAR();
    SLOAD(SO, (j + SDEPTH) * KVBLK); SBAR();
    pv_d0(o, vb0, pa0, pa1, pa2, pa3); partialSM(pB0, pB1, m_reg, mnB, alB);
    __syncthreads(); SWAIT(); SWRITE(0, SE);
    RESC(alB); __syncthreads();
    SBAR(); qkt(pA0, pA1, K_lds, qr, r32, hi);
    finishSM(pB0, pB1, alB, l_reg, pa0, pa1, pa2, pa3); SBAR();
    if (SDEPTH == 1 || j + 3 < NT) SLOAD(SE, (j + 1 + SDEPTH) * KVBLK); SBAR();
    pv_d0(o, vb0 + (int)SHM_V, pa0, pa1, pa2, pa3); partialSM(pA0, pA1, m_reg, mnA, alA);
    __syncthreads(); SWAIT(); SWRITE(1, SO);
    RESC(alA); __syncthreads();
  }
  SBAR(); qkt(pB0, pB1, (bf16*)((char*)K_lds + SHM_K), qr, r32, hi);
  finishSM(pA0, pA1, alA, l_reg, pa0, pa1, pa2, pa3); SBAR();
  pv_d0(o, vb0, pa0, pa1, pa2, pa3); partialSM(pB0, pB1, m_reg, mnB, alB);
  __syncthreads(); RESC(alB);
  finishSM(pB0, pB1, alB, l_reg, pa0, pa1, pa2, pa3); SBAR();
  pv_d0(o, vb0 + (int)SHM_V, pa0, pa1, pa2, pa3);
  if (hi == 0) li_l[r32] = l_reg; asm volatile("s_waitcnt lgkmcnt(0)" ::: "memory");
  float rli[16];
#pragma unroll
  for (int r = 0; r < 16; ++r) rli[r] = __builtin_amdgcn_rcpf(li_l[crow(r, hi)]);
  float* Ow = Ob + (long)(wid * QBLK) * LDO;
#pragma unroll
  for (int r = 0; r < 16; ++r) { int orow = crow(r, hi);
    for (int d0 = 0; d0 < 4; ++d0) Ow[(long)orow * LDO + d0 * 32 + r32] = o[d0][r] * rli[r]; }
#undef SLOAD
#undef SWRITE
#undef SWAIT
#undef RESC
}

constexpr size_t SHM_V8 = KVBLK * 256 * 2;
constexpr size_t SHM_ATTN8 = 2 * SHM_V8 + 2 * SHM_K + NW * 64 * 4;
__device__ __forceinline__ int v_st8(int k, int c) { const int kk = (k & ~0xC) | ((k & 4) << 1) | ((k & 8) >> 1); return ((kk >> 3) * 8 + (c >> 5)) * 512 + ((kk & 7) * 32 + (c & 31)) * 2; }
constexpr int v_rd_off8(int d0, int ks, int half) { return d0 * 512 + ks * 8192 + half * 4096; }
template <int D0> __device__ __forceinline__ void pv_one8(f32x16& od, int vb, bf16x8 pa0, bf16x8 pa1, bf16x8 pa2, bf16x8 pa3) {
  const s16x4 l0 = tr_read<v_rd_off8(D0, 0, 0)>(vb), h0 = tr_read<v_rd_off8(D0, 0, 1)>(vb), l1 = tr_read<v_rd_off8(D0, 1, 0)>(vb), h1 = tr_read<v_rd_off8(D0, 1, 1)>(vb);
  const s16x4 l2 = tr_read<v_rd_off8(D0, 2, 0)>(vb), h2 = tr_read<v_rd_off8(D0, 2, 1)>(vb), l3 = tr_read<v_rd_off8(D0, 3, 0)>(vb), h3 = tr_read<v_rd_off8(D0, 3, 1)>(vb);
  asm volatile("s_waitcnt lgkmcnt(0)" ::: "memory"); SBAR();
#define PK(L, H) (bf16x8){L[0], L[1], L[2], L[3], H[0], H[1], H[2], H[3]}
  od = __builtin_amdgcn_mfma_f32_32x32x16_bf16(pa0, PK(l0, h0), od, 0, 0, 0);
  od = __builtin_amdgcn_mfma_f32_32x32x16_bf16(pa1, PK(l1, h1), od, 0, 0, 0);
  od = __builtin_amdgcn_mfma_f32_32x32x16_bf16(pa2, PK(l2, h2), od, 0, 0, 0);
  od = __builtin_amdgcn_mfma_f32_32x32x16_bf16(pa3, PK(l3, h3), od, 0, 0, 0);
#undef PK
}
__device__ __forceinline__ void attn_dv256_body(const bf16* __restrict__ Qb, const bf16* __restrict__ Kh, const bf16* __restrict__ Vh,
                                                float* __restrict__ Ob, int seq, char* lds, __attribute__((address_space(3))) unsigned char* ldsl, int tid_in,
                                                int mode, float lam, float post, const float* __restrict__ nw, unsigned short* __restrict__ A2b) {
  int tid_l = tid_in; asm volatile("" : "+v"(tid_l)); const int tid = tid_l, wid = __builtin_amdgcn_readfirstlane(tid >> 6), lane = tid & 63, r32 = lane & 31, hi = lane >> 5;
  bf16* V_lds = (bf16*)lds; bf16* K_lds = (bf16*)(lds + 2 * SHM_V8);
  float* ws = (float*)(lds + 2 * SHM_V8 + 2 * SHM_K) + wid * 64; float* li_l = ws; float* al_l = ws + 32;
  float m_reg = -1e30f, l_reg = 0; f32x16 o[8] = {}; bf16x8 qr[8];
  const bf16* Qw = Qb + (long)(wid * QBLK + r32) * LDQ + hi * 8;
#pragma unroll
  for (int d0 = 0; d0 < 8; ++d0) qr[d0] = *reinterpret_cast<const bf16x8*>(Qw + d0 * 16);
  int koff[2], voff[4];
#pragma unroll
  for (int t = 0; t < 2; ++t) { const int b = (wid * 2 + t) * 1024 + lane * 16; const int row = b >> 8, colB = (b & 255) ^ ((row & 7) << 4); koff[t] = row * LDK + (colB >> 1); }
#pragma unroll
  for (int t = 0; t < 4; ++t) { const int b = (wid * 4 + t) * 1024 + lane * 16; const int sub = b >> 9, w = b & 511, kk = ((sub >> 3) << 3) | (w >> 6), c = ((sub & 7) << 5) | ((w & 63) >> 1);
    const int k = (kk & ~0xC) | ((kk & 4) << 1) | ((kk & 8) >> 1); voff[t] = k * LDK + c; }
  const int vb0 = (int)(uintptr_t)V_lds + v_rd_base(lane);
#define DSTAGE(buf, k0) do { \
    _Pragma("unroll") for (int t = 0; t < 2; ++t) __builtin_amdgcn_global_load_lds((const unsigned*)(Kh + (long)(k0) * LDK + koff[t]), (__attribute__((address_space(3))) unsigned*)(ldsl + 2 * SHM_V8 + (buf) * SHM_K + (wid * 2 + t) * 1024), 16, 0, 0); \
    _Pragma("unroll") for (int t = 0; t < 4; ++t) __builtin_amdgcn_global_load_lds((const unsigned*)(Vh + (long)(k0) * LDK + voff[t]), (__attribute__((address_space(3))) unsigned*)(ldsl + (buf) * SHM_V8 + (wid * 4 + t) * 1024), 16, 0, 0); } while (0)
#define RESC8(a) do { if (__any((a) < 1.f)) { if (hi == 0) al_l[r32] = (a); asm volatile("s_waitcnt lgkmcnt(0)" ::: "memory"); \
    _Pragma("unroll") for (int d = 0; d < 8; ++d) _Pragma("unroll") for (int r = 0; r < 16; ++r) o[d][r] *= al_l[crow(r, hi)]; } } while (0)
  const int NT = seq / KVBLK;
  DSTAGE(0, 0); asm volatile("s_waitcnt vmcnt(0)" ::: "memory"); __syncthreads();
#pragma unroll 1
  for (int j = 0; j < NT; ++j) {
    const int b = j & 1;
    if (j + 1 < NT) DSTAGE(b ^ 1, (j + 1) * KVBLK);
    f32x16 p0, p1; SBAR(); qkt(p0, p1, (const bf16*)((const char*)K_lds + b * SHM_K), qr, r32, hi); SBAR();
    float mn, alpha; partialSM(p0, p1, m_reg, mn, alpha);
    RESC8(alpha);
    bf16x8 pa0, pa1, pa2, pa3; finishSM(p0, p1, alpha, l_reg, pa0, pa1, pa2, pa3); SBAR();
    const int vb = vb0 + b * (int)SHM_V8;
    pv_one8<0>(o[0], vb, pa0, pa1, pa2, pa3); pv_one8<1>(o[1], vb, pa0, pa1, pa2, pa3); pv_one8<2>(o[2], vb, pa0, pa1, pa2, pa3); pv_one8<3>(o[3], vb, pa0, pa1, pa2, pa3);
    pv_one8<4>(o[4], vb, pa0, pa1, pa2, pa3); pv_one8<5>(o[5], vb, pa0, pa1, pa2, pa3); pv_one8<6>(o[6], vb, pa0, pa1, pa2, pa3); pv_one8<7>(o[7], vb, pa0, pa1, pa2, pa3);
    asm volatile("s_waitcnt vmcnt(0)" ::: "memory");
    __syncthreads();
  }
  if (hi == 0) li_l[r32] = l_reg; asm volatile("s_waitcnt lgkmcnt(0)" ::: "memory");
  float rli[16];
#pragma unroll
  for (int r = 0; r < 16; ++r) rli[r] = __builtin_amdgcn_rcpf(li_l[crow(r, hi)]);
  float* Ow = Ob + (long)(wid * QBLK) * LDO;
  if (mode == 0) {
#pragma unroll
    for (int r = 0; r < 16; ++r) { const int orow = crow(r, hi);
#pragma unroll
      for (int d0 = 0; d0 < 8; ++d0) Ow[(long)orow * LDO + d0 * 32 + r32] = o[d0][r] * rli[r]; }
  } else {
    unsigned short* Aw = A2b + (long)(wid * QBLK) * LDO;
    float nwv[8];
#pragma unroll
    for (int d0 = 0; d0 < 8; ++d0) nwv[d0] = nw[d0 * 32 + r32] * post;
#pragma unroll
    for (int r = 0; r < 16; ++r) { const int orow = crow(r, hi); float v[8]; float ss = 0.f;
#pragma unroll
      for (int d0 = 0; d0 < 8; ++d0) { v[d0] = Ow[(long)orow * LDO + d0 * 32 + r32] - lam * (o[d0][r] * rli[r]); ss += v[d0] * v[d0]; }
      ss += __int_as_float(__builtin_amdgcn_ds_swizzle(__float_as_int(ss), (1 << 10) | 0x1f)); ss += __int_as_float(__builtin_amdgcn_ds_swizzle(__float_as_int(ss), (2 << 10) | 0x1f));
      ss += __int_as_float(__builtin_amdgcn_ds_swizzle(__float_as_int(ss), (4 << 10) | 0x1f)); ss += __int_as_float(__builtin_amdgcn_ds_swizzle(__float_as_int(ss), (8 << 10) | 0x1f));
      ss += __int_as_float(__builtin_amdgcn_ds_swizzle(__float_as_int(ss), (16 << 10) | 0x1f));
      const float rr = 1.0f / sqrtf(ss * (1.0f / 256.0f) + 1e-6f);
#pragma unroll
      for (int d0 = 0; d0 < 8; ++d0) { const float x = v[d0] * rr * nwv[d0]; unsigned u = __builtin_bit_cast(unsigned, x); u = (u + 0x7fffu + ((u >> 16) & 1u)) >> 16; Aw[(long)orow * LDO + d0 * 32 + r32] = (unsigned short)u; } }
  }
#undef DSTAGE
#undef RESC8
}
}
#ifndef MK_SPLIT
#define MK_SPLIT 0
#endif
#define LAS __attribute__((address_space(3)))
typedef unsigned short bf16_t;
typedef float f32x4 __attribute__((ext_vector_type(4)));
typedef short bf16x8 __attribute__((ext_vector_type(8)));
typedef unsigned u32x4 __attribute__((ext_vector_type(4)));
typedef unsigned u32x2 __attribute__((ext_vector_type(2)));

#define XB_TMO      128
#define XB_XCNT(j)  (256  + 64 * (j))
#define XB_XSUB(j)  (1280 + 64 * (j))
#define XB_XGEN(j)  (2304 + 64 * (j))
#define XB_TOP      3328
#define XB_TOPGEN   3392
#define XCD_BAR_WORDS 3456
#define XB_SPIN_CAP (1u << 18)

__device__ __forceinline__ unsigned xb_ld(unsigned* p)              { return __hip_atomic_load(p, __ATOMIC_RELAXED, __HIP_MEMORY_SCOPE_AGENT); }
__device__ __forceinline__ unsigned xb_add(unsigned* p, unsigned v) { return __hip_atomic_fetch_add(p, v, __ATOMIC_RELAXED, __HIP_MEMORY_SCOPE_AGENT); }
__device__ __forceinline__ unsigned xb_xcc_id() { return (unsigned)__builtin_amdgcn_s_getreg((3 << 11) | 20) & 0xFu; }
#define XB_SPIN(cond, bar) do { unsigned _sp = 0; while (cond) { __builtin_amdgcn_s_sleep(1); \
    if ((++_sp & 255u) == 0u) { if (xb_ld(&(bar)[XB_TMO])) break; if (_sp > XB_SPIN_CAP) { atomicAdd(&(bar)[XB_TMO], 1u); break; } } } } while (0)

struct XcdBarrier {
    unsigned* bar; unsigned x;
    volatile LAS unsigned* st;
};

__device__ __forceinline__ XcdBarrier xcd_barrier_post(unsigned* bar, volatile LAS unsigned* st) {
    XcdBarrier b; b.bar = bar; b.x = xb_xcc_id(); b.st = st;
    if (threadIdx.x == 0) (void)xb_add(&bar[XB_XCNT(b.x)], 1u);
    return b;
}
__device__ __forceinline__ void xcd_barrier_complete(unsigned* bar, unsigned x, unsigned& nloc, unsigned& nx) {
    const unsigned G = gridDim.x * gridDim.y * gridDim.z;
    unsigned sum, cnt, mine, sp = 0u;
    for (;;) {
        sum = 0u; cnt = 0u; mine = 0u;
#pragma unroll
        for (unsigned j = 0; j < 16; ++j) { const unsigned c = xb_ld(&bar[XB_XCNT(j)]); sum += c; cnt += (c > 0u) ? 1u : 0u; mine = (j == x) ? c : mine; }
        if (sum == G) break;
        __builtin_amdgcn_s_sleep(1);
        if ((++sp & 255u) == 0u) { if (xb_ld(&bar[XB_TMO])) break; if (sp > XB_SPIN_CAP) { atomicAdd(&bar[XB_TMO], 1u); break; } }
    }
    nloc = mine > 0u ? mine : 1u; nx = cnt > 0u ? cnt : 1u;
}

__device__ __forceinline__ void xcd_barrier(const XcdBarrier& b) {
    asm volatile("s_waitcnt vmcnt(0)" ::: "memory");
    __syncthreads();
    if (threadIdx.x == 0) {
        unsigned* bar = b.bar;
        __builtin_amdgcn_s_waitcnt(0);
        unsigned nloc = b.st[0], nx = b.st[1];
        if (nloc == 0u) { xcd_barrier_complete(bar, b.x, nloc, nx); b.st[0] = nloc; b.st[1] = nx; }
        const unsigned old = xb_add(&bar[XB_XSUB(b.x)], 1u);
        const unsigned gen = old / nloc;
        if (old + 1u == (gen + 1u) * nloc) {
            __builtin_amdgcn_fence(__ATOMIC_RELEASE, "agent");
            asm volatile("s_waitcnt vmcnt(0)" ::: "memory");
            const unsigned og = xb_add(&bar[XB_TOP], 1u);
            const unsigned tg = og / nx;
            if (og + 1u == (tg + 1u) * nx) xb_add(&bar[XB_TOPGEN], 1u);
            else XB_SPIN(xb_ld(&bar[XB_TOPGEN]) == tg, bar);
            __builtin_amdgcn_fence(__ATOMIC_ACQUIRE, "agent");
            xb_add(&bar[XB_XGEN(b.x)], 1u);
            asm volatile("s_waitcnt vmcnt(0)" ::: "memory");
        } else {
            XB_SPIN(xb_ld(&bar[XB_XGEN(b.x)]) == gen, bar);
            __builtin_amdgcn_fence(__ATOMIC_ACQUIRE, "agent");
            asm volatile("s_waitcnt vmcnt(0)" ::: "memory");
        }
    }
    __syncthreads();
}

constexpr int DM = 2048, SEQ = 8192, CTXL = 256, MROWS = SEQ + CTXL, DFF = 5632, NMOD = 9 * DM;
constexpr int IN0 = 4128, IN0P = 4352, QKVN = 6144;
constexpr int C_Q = 0, C_K = 512, C_V = 1024, C_R = 2048, C_GF = 3072, C_U = 3104;
constexpr int NCHUNK = 132, NITEM = 8 * NCHUNK;
constexpr float EPS = 1e-6f;
constexpr int ADA_KC = 16;

constexpr size_t MiB = 1u << 20;
constexpr size_t WS_MOD = 0, WS_ADAP = 1 * MiB, WS_ROPEC = 6 * MiB, WS_ROPES = 8 * MiB, WS_POOLW = 10 * MiB, WS_GLAD = 11 * MiB;
constexpr size_t WS_W13 = 12 * MiB, WS_W2 = 188 * MiB, WS_WIN = 276 * MiB, WS_WOUT0 = 293 * MiB, WS_WQKV = 301 * MiB, WS_WOUT1 = 325 * MiB;
constexpr size_t WS_H = 333 * MiB, WS_Z = 399 * MiB, WS_U = 432 * MiB, WS_PROJ = 523 * MiB, WS_A2 = 622 * MiB, WS_POOLED = 655 * MiB;
constexpr size_t WS_L = 672 * MiB, WS_STB = 804 * MiB, WS_OF = 870 * MiB, WS_OB = 903 * MiB, WS_ATT0 = 672 * MiB, WS_ATT1 = 736 * MiB, WS_CTL = 936 * MiB, WS_PART = 937 * MiB, WS_BCUM = 960 * MiB, WS_END = 994 * MiB;
constexpr size_t CTL_ZERO_BYTES = 16384;
constexpr size_t W13_BYTES = (size_t)2 * DFF * DM * 2, W2_BYTES = (size_t)DM * DFF * 2;
static_assert(WS_W13 + 4 * W13_BYTES <= WS_W2 && WS_W2 + 4 * W2_BYTES <= WS_WIN && WS_WIN + (size_t)IN0P * DM * 2 <= WS_WOUT0 && WS_WQKV + (size_t)QKVN * DM * 2 <= WS_WOUT1, "ws map (weights)");
static_assert(WS_H + (size_t)MROWS * DM * 4 <= WS_Z && WS_Z + (size_t)MROWS * DM * 2 <= WS_U && WS_U + (size_t)MROWS * DFF * 2 <= WS_PROJ && WS_PROJ + (size_t)MROWS * QKVN * 2 <= WS_A2, "ws map (act)");
static_assert(WS_A2 + (size_t)MROWS * DM * 2 <= WS_POOLED && WS_POOLED + (size_t)4 * MROWS * 256 * 2 <= WS_L && WS_L + (size_t)NITEM * 32768 * 4 <= WS_STB && WS_STB + (size_t)NITEM * 32768 * 2 <= WS_OF, "ws map (gla)");
static_assert(WS_OF + (size_t)MROWS * 1024 * 4 <= WS_OB && WS_OB + (size_t)MROWS * 1024 * 4 <= WS_CTL && XCD_BAR_WORDS * 4 <= CTL_ZERO_BYTES && WS_ATT1 + (size_t)SEQ * DM * 4 <= WS_STB, "ws map (out)");

constexpr int LDS_BYTES = 147456;

__device__ __forceinline__ unsigned f2bf(float f) { unsigned u = __builtin_bit_cast(unsigned, f); return (u + 0x7fffu + ((u >> 16) & 1u)) >> 16; }
__device__ __forceinline__ unsigned pk2(float lo, float hi) { return f2bf(lo) | (f2bf(hi) << 16); }
__device__ __forceinline__ float bf2f(unsigned v) { return __uint_as_float(v << 16); }
__device__ __forceinline__ float bfel(const u32x4& r, int j) { return __uint_as_float(((r[j >> 1] >> ((j & 1) * 16)) & 0xffffu) << 16); }
__device__ __forceinline__ unsigned bfraw(const u32x4& r, int j) { return (r[j >> 1] >> ((j & 1) * 16)) & 0xffffu; }
template <int X> __device__ __forceinline__ float xor_add(float v) { return v + __int_as_float(__builtin_amdgcn_ds_swizzle(__float_as_int(v), (X << 10) | 0x1f)); }
__device__ __forceinline__ float wave_sum(float v) {
    v = xor_add<1>(v); v = xor_add<2>(v); v = xor_add<4>(v); v = xor_add<8>(v); v = xor_add<16>(v);
    auto rr = __builtin_amdgcn_permlane32_swap(__float_as_uint(v), __float_as_uint(v), false, false);
    return __uint_as_float(rr[0]) + __uint_as_float(rr[1]);
}
__device__ __forceinline__ float silu_x(float x) { return x / (1.0f + __expf(-x)); }
__device__ __forceinline__ float log_sigmoid_f(float z) { return fminf(z, 0.f) - __logf(1.0f + __expf(-fabsf(z))); }

template <int MODE> __device__ __forceinline__ int rowmap(int n, int aux) {
    if (MODE == 0) return n + aux;
    if (MODE == 1) return (n >> 7) * 256 + aux * 128 + (n & 127);
    if (n >= 4096) return n;
    const int d = n & 127; return (n & ~127) + 8 * ((d & 63) >> 2) + 4 * (d >> 6) + (d & 3);
}
template <int MODE> __device__ __forceinline__ void transpose_item(const float* __restrict__ W, int K, int N, bf16_t* __restrict__ WT, int aux, LAS float* scr, int item, int lane) {
    const int nblk = N / 32, kb = item / nblk, nb = item % nblk, k0 = 64 * kb, n0 = 32 * nb;
#pragma unroll 8
    for (int i = 0; i < 32; ++i) { const int kk = 2 * i + (lane >> 5); scr[kk * 33 + (lane & 31)] = W[(size_t)(k0 + kk) * N + n0 + (lane & 31)]; }
    asm volatile("s_waitcnt lgkmcnt(0)" ::: "memory");
    const int c = lane & 7;
#pragma unroll
    for (int j = 0; j < 4; ++j) { const int n = (lane >> 3) + 8 * j; const LAS float* s = scr + (8 * c) * 33 + n;
        u32x4 o; o.x = pk2(s[0 * 33], s[1 * 33]); o.y = pk2(s[2 * 33], s[3 * 33]); o.z = pk2(s[4 * 33], s[5 * 33]); o.w = pk2(s[6 * 33], s[7 * 33]);
        *(u32x4*)(WT + (size_t)rowmap<MODE>(n0 + n, aux) * K + k0 + 8 * c) = o; }
    asm volatile("s_waitcnt lgkmcnt(0)" ::: "memory");
}
struct RowBuf { f32x4 v[8]; u32x2 d[8]; };
__device__ __forceinline__ void row_load(RowBuf& b, const float* __restrict__ src, const bf16_t* __restrict__ dl, int lane) {
    const f32x4* hr = (const f32x4*)src + lane;
#pragma unroll
    for (int j = 0; j < 8; ++j) b.v[j] = hr[64 * j];
    if (dl) { const u32x2* dr = (const u32x2*)dl + lane;
#pragma unroll
        for (int j = 0; j < 8; ++j) b.d[j] = dr[64 * j]; }
}
__device__ __forceinline__ float row_finish(RowBuf& b, bool has_d) {
    float ss = 0.f;
#pragma unroll
    for (int j = 0; j < 8; ++j) {
        if (has_d) { b.v[j].x += bf2f(b.d[j].x & 0xffffu); b.v[j].y += bf2f(b.d[j].x >> 16); b.v[j].z += bf2f(b.d[j].y & 0xffffu); b.v[j].w += bf2f(b.d[j].y >> 16); }
        ss += (b.v[j].x * b.v[j].x + b.v[j].y * b.v[j].y) + (b.v[j].z * b.v[j].z + b.v[j].w * b.v[j].w); }
    return 1.0f / sqrtf(wave_sum(ss) * (1.0f / DM) + EPS);
}
__device__ __forceinline__ void norm_mod_phase(const float* __restrict__ srcL, const float* __restrict__ srcC, const bf16_t* __restrict__ DL, float* __restrict__ H, bool wbL, bool wbC,
                                               const float* __restrict__ PART, int nparts, bf16_t* __restrict__ Z, const float* mod_lat, const float* mod_ctx, int slot, int nrows_in, int gw, int NGW, int lane,
                                               LAS unsigned char* lds, int bx, int G, int wave) {
    if (nrows_in > SEQ) {
        LAS float* red = (LAS float*)lds;
        for (int cr = bx; cr < CTXL; cr += G) {
            const int col = wave * 256 + lane * 4;
            f32x4 v = *(const f32x4*)(srcC + (size_t)cr * DM + col);
            f32x4 ps[11];
#pragma unroll
            for (int ks = 0; ks < 11; ++ks) ps[ks] = (ks < nparts) ? *(const f32x4*)(PART + ((size_t)ks * 256 + cr) * DM + col) : (f32x4){0.f, 0.f, 0.f, 0.f};
#pragma unroll
            for (int ks = 0; ks < 11; ++ks) v = v + ps[ks];
            const float ssw = wave_sum((v.x * v.x + v.y * v.y) + (v.z * v.z + v.w * v.w));
            if (lane == 0) red[wave] = ssw;
            __syncthreads();
            const float tot = ((red[0] + red[1]) + (red[2] + red[3])) + ((red[4] + red[5]) + (red[6] + red[7]));
            const float rr = 1.0f / sqrtf(tot * (1.0f / DM) + EPS);
            const float* sh = mod_ctx + (size_t)slot * DM; const float* sc = sh + DM;
            if (wbC || nparts > 0) *(f32x4*)(H + (size_t)(SEQ + cr) * DM + col) = v;
            const f32x4 o = v * rr * (*(const f32x4*)(sc + col) + 1.0f) + *(const f32x4*)(sh + col);
            *(unsigned long long*)(Z + (size_t)(SEQ + cr) * DM + col) = (unsigned long long)pk2(o.x, o.y) | ((unsigned long long)pk2(o.z, o.w) << 32);
            __syncthreads();
        }
    }
    const int nrows = nrows_in < SEQ ? nrows_in : SEQ;
    RowBuf A, B;
    f32x4 sc1[8], shv[8]; int kind = -1;
#define NM_SRC(r) ((r) < SEQ ? srcL + (size_t)(r) * DM : srcC + (size_t)((r) - SEQ) * DM)
#define NM_DL(r) (((r) < SEQ && DL) ? DL + (size_t)(r) * DM : (const bf16_t*)nullptr)
#define NM_DO(buf, r) do { const bool ctxr = (r) >= SEQ; \
        if (ctxr) { for (int ks = 0; ks < nparts; ++ks) { const f32x4* pr = (const f32x4*)(PART + ((size_t)ks * 256 + ((r) - SEQ)) * DM) + lane; _Pragma("unroll") for (int j = 0; j < 8; ++j) buf.v[j] = buf.v[j] + pr[64 * j]; } } \
        const float rr = row_finish(buf, !ctxr && DL != nullptr); \
        if (kind != (int)ctxr) { kind = (int)ctxr; const float* sh = (ctxr ? mod_ctx : mod_lat) + (size_t)slot * DM; const float* sc = sh + DM; \
            _Pragma("unroll") for (int j = 0; j < 8; ++j) { const int col = 4 * lane + 256 * j; sc1[j] = *(const f32x4*)(sc + col) + 1.0f; shv[j] = *(const f32x4*)(sh + col); } } \
        if (ctxr ? (wbC || nparts > 0) : wbL) { f32x4* ho = (f32x4*)(H + (size_t)(r) * DM) + lane; _Pragma("unroll") for (int j = 0; j < 8; ++j) ho[64 * j] = buf.v[j]; } \
        unsigned long long* zo = (unsigned long long*)(Z + (size_t)(r) * DM) + lane; \
        _Pragma("unroll") for (int j = 0; j < 8; ++j) { \
            const f32x4 o = buf.v[j] * rr * sc1[j] + shv[j]; zo[64 * j] = (unsigned long long)pk2(o.x, o.y) | ((unsigned long long)pk2(o.z, o.w) << 32); } } while (0)
    int row = nrows - 1 - gw;
    if (row >= 0) row_load(A, NM_SRC(row), NM_DL(row), lane);
    while (row >= 0) {
        const int r1 = row - NGW; if (r1 >= 0) row_load(B, NM_SRC(r1), NM_DL(r1), lane);
        NM_DO(A, row);
        if (r1 < 0) break;
        const int r2 = r1 - NGW; if (r2 >= 0) row_load(A, NM_SRC(r2), NM_DL(r2), lane);
        NM_DO(B, r1);
        row = r2;
    }
#undef NM_SRC
#undef NM_DL
#undef NM_DO
}
__device__ __forceinline__ void final_norm_phase(const float* __restrict__ H, const bf16_t* __restrict__ DL, float* __restrict__ out, const float* __restrict__ fnw, int gw, int NGW, int lane) {
    RowBuf A, B;
#define FN_DO(buf, r) do { const float rr = row_finish(buf, DL != nullptr); f32x4* o = (f32x4*)(out + (size_t)(r) * DM) + lane; \
        _Pragma("unroll") for (int j = 0; j < 8; ++j) { const f32x4 w4 = *(const f32x4*)(fnw + 4 * lane + 256 * j); o[64 * j] = buf.v[j] * rr * w4; } } while (0)
    int row = gw;
    if (row < SEQ) row_load(A, H + (size_t)row * DM, DL ? DL + (size_t)row * DM : DL, lane);
    while (row < SEQ) {
        const int r1 = row + NGW; if (r1 < SEQ) row_load(B, H + (size_t)r1 * DM, DL ? DL + (size_t)r1 * DM : DL, lane);
        FN_DO(A, row);
        if (r1 >= SEQ) break;
        const int r2 = r1 + NGW; if (r2 < SEQ) row_load(A, H + (size_t)r2 * DM, DL ? DL + (size_t)r2 * DM : DL, lane);
        FN_DO(B, r1);
        row = r2;
    }
#undef FN_DO
}
__device__ __forceinline__ void gla_readout_phase(const float* __restrict__ OF, const float* __restrict__ OB, const bf16_t* __restrict__ PROJ, const float* __restrict__ nw, bf16_t* __restrict__ A2, int gw, int NGW, int lane) {
    const int c0 = (lane & 15) * 16;
    float nwv[16];
#pragma unroll
    for (int j = 0; j < 16; ++j) nwv[j] = nw[c0 + j];
    struct RB { f32x4 a[4], b[4]; u32x4 r0, r1; };
#define RD_LOAD(B_, r_) do { const f32x4* a_ = (const f32x4*)(OF + (size_t)(r_) * 1024 + lane * 16); const f32x4* b_ = (const f32x4*)(OB + (size_t)(r_) * 1024 + lane * 16); \
        _Pragma("unroll") for (int j = 0; j < 4; ++j) { B_.a[j] = a_[j]; B_.b[j] = b_[j]; } \
        const u32x4* rp_ = (const u32x4*)(PROJ + (size_t)(r_) * IN0P + C_R + lane * 16); B_.r0 = rp_[0]; B_.r1 = rp_[1]; } while (0)
#define RD_DO(B_, r_) do { f32x4 v[4]; float ss = 0.f; \
        _Pragma("unroll") for (int j = 0; j < 4; ++j) { v[j] = B_.a[j] + B_.b[j]; ss += (v[j].x * v[j].x + v[j].y * v[j].y) + (v[j].z * v[j].z + v[j].w * v[j].w); } \
        ss = xor_add<1>(ss); ss = xor_add<2>(ss); ss = xor_add<4>(ss); ss = xor_add<8>(ss); \
        const float r = 1.0f / sqrtf(ss * (1.0f / 256.0f) + EPS); float o[16]; \
        _Pragma("unroll") for (int j = 0; j < 16; ++j) { const float rv = (j < 8) ? bfel(B_.r0, j) : bfel(B_.r1, j - 8); o[j] = v[j >> 2][j & 3] * r * nwv[j] * (rv * __builtin_amdgcn_rcpf(1.0f + __expf(-rv))); } \
        u32x4 w0, w1; w0.x = pk2(o[0], o[1]); w0.y = pk2(o[2], o[3]); w0.z = pk2(o[4], o[5]); w0.w = pk2(o[6], o[7]); w1.x = pk2(o[8], o[9]); w1.y = pk2(o[10], o[11]); w1.z = pk2(o[12], o[13]); w1.w = pk2(o[14], o[15]); \
        u32x4* op = (u32x4*)(A2 + (size_t)(r_) * DM + lane * 16); op[0] = w0; op[1] = w1; } while (0)
    {
        const int wv = gw & 7, bxr = gw >> 3, Gr = NGW >> 3;
        if (wv < 4) for (int cr = bxr; cr < CTXL; cr += Gr) { const int row = SEQ + cr, col = wv * 256 + lane * 4;
            const f32x4 v = *(const f32x4*)(OF + (size_t)row * 1024 + col) + *(const f32x4*)(OB + (size_t)row * 1024 + col);
            const unsigned long long rw = *(const unsigned long long*)(PROJ + (size_t)row * IN0P + C_R + col);
            const float ss = wave_sum((v.x * v.x + v.y * v.y) + (v.z * v.z + v.w * v.w));
            const float r = 1.0f / sqrtf(ss * (1.0f / 256.0f) + EPS);
            const f32x4 n4 = *(const f32x4*)(nw + lane * 4);
            const float r0 = bf2f((unsigned)(rw & 0xffffu)), r1 = bf2f((unsigned)((rw >> 16) & 0xffffu)), r2 = bf2f((unsigned)((rw >> 32) & 0xffffu)), r3 = bf2f((unsigned)(rw >> 48));
            const float o0 = v.x * r * n4.x * silu_x(r0), o1 = v.y * r * n4.y * silu_x(r1), o2 = v.z * r * n4.z * silu_x(r2), o3 = v.w * r * n4.w * silu_x(r3);
            *(unsigned long long*)(A2 + (size_t)row * DM + col) = (unsigned long long)pk2(o0, o1) | ((unsigned long long)pk2(o2, o3) << 32); }
    }
    RB A, B;
    int row = gw;
    if (row < SEQ) RD_LOAD(A, row);
    while (row < SEQ) {
        const int r1 = row + NGW; if (r1 < SEQ) RD_LOAD(B, r1);
        RD_DO(A, row);
        if (r1 >= SEQ) break;
        const int r2 = r1 + NGW; if (r2 < SEQ) RD_LOAD(A, r2);
        RD_DO(B, r1);
        row = r2;
    }
#undef RD_LOAD
#undef RD_DO
}
__device__ __forceinline__ void diff_combine_phase(const float* __restrict__ A0, const float* __restrict__ A1, const float* __restrict__ lp, const float* __restrict__ nw, bf16_t* __restrict__ A2, int gw, int NGW, int lane) {
    const float lam_init = 0.8f - 0.6f * 0.74081822068171786607f;
    const float s01 = wave_sum(lp[lane] * lp[128 + lane] + lp[64 + lane] * lp[192 + lane]);
    const float s23 = wave_sum(lp[256 + lane] * lp[384 + lane] + lp[320 + lane] * lp[448 + lane]);
    const float lam = expf(s01) - expf(s23) + lam_init;
    const float post = 1.0f - lam_init;
    for (int row = gw; row < SEQ; row += NGW) {
        const f32x4* a = (const f32x4*)(A0 + (size_t)row * DM + lane * 32); const f32x4* b = (const f32x4*)(A1 + (size_t)row * DM + lane * 32);
        f32x4 v[8]; float ss = 0.f;
#pragma unroll
        for (int j = 0; j < 8; ++j) { v[j] = a[j] - b[j] * lam; ss += (v[j].x * v[j].x + v[j].y * v[j].y) + (v[j].z * v[j].z + v[j].w * v[j].w); }
        ss = xor_add<1>(ss); ss = xor_add<2>(ss); ss = xor_add<4>(ss);
        const float r = post / sqrtf(ss * (1.0f / 256.0f) + EPS);
        const int c0 = (lane & 7) * 32;
        u32x4* op = (u32x4*)(A2 + (size_t)row * DM + lane * 32);
#pragma unroll
        for (int j = 0; j < 4; ++j) { const f32x4 w0 = *(const f32x4*)(nw + c0 + 8 * j), w1 = *(const f32x4*)(nw + c0 + 8 * j + 4); const f32x4 x0 = v[2 * j] * r * w0, x1 = v[2 * j + 1] * r * w1;
            u32x4 w; w.x = pk2(x0.x, x0.y); w.y = pk2(x0.z, x0.w); w.z = pk2(x1.x, x1.y); w.w = pk2(x1.z, x1.w); op[j] = w; }
    }
}
__device__ __forceinline__ void pool_phase(const bf16_t* __restrict__ PROJ, bf16_t* __restrict__ POOLED, int gtid, int NT) {
    for (int idx = gtid; idx < MROWS * 128; idx += NT) {
        const int row = idx >> 7, c8 = idx & 127, g = c8 >> 5, hw = 1 << g;
        const int L0 = row < SEQ ? 0 : SEQ, L1 = row < SEQ ? SEQ : MROWS;
        const int lo = max(row - hw, L0), hi = min(row + hw, L1);
        float s[8];
#pragma unroll
        for (int j = 0; j < 8; ++j) s[j] = 0.f;
        u32x4 xs[16];
#pragma unroll
        for (int i = 0; i < 16; ++i) { const int r = lo + i; xs[i] = (r < hi) ? *(const u32x4*)(PROJ + (size_t)r * IN0P + C_U + c8 * 8) : (u32x4){0u, 0u, 0u, 0u}; }
#pragma unroll
        for (int i = 0; i < 16; ++i) {
#pragma unroll
            for (int j = 0; j < 8; ++j) s[j] += bfel(xs[i], j); }
        const u32x4 x = *(const u32x4*)(PROJ + (size_t)row * IN0P + C_U + c8 * 8);
        const float inv = 1.0f / (float)(hi - lo);
        float o[8];
#pragma unroll
        for (int j = 0; j < 8; ++j) o[j] = s[j] * inv - bfel(x, j);
        u32x4 w; w.x = pk2(o[0], o[1]); w.y = pk2(o[2], o[3]); w.z = pk2(o[4], o[5]); w.w = pk2(o[6], o[7]);
        *(u32x4*)(POOLED + ((size_t)g * MROWS + row) * 256 + (c8 & 31) * 8) = w;
    }
}

constexpr int GL_GZ = 0, GL_W2 = 4096, GL_BI = 12288, GL_G = 13312, GL_GS = 129;
__device__ __forceinline__ int gla_base(int dir, int c) { return dir == 0 ? (c < 4 ? SEQ + 64 * c : 64 * (c - 4)) : (c < 4 ? SEQ + 192 - 64 * c : SEQ - 64 - 64 * (c - 4)); }
__device__ __forceinline__ void gla_gates(LAS unsigned char* lds, const bf16_t* __restrict__ PROJ, int base, int dir, int head, const float* __restrict__ gw2, const float* __restrict__ gb, int tid) {
    LAS float* GZ = (LAS float*)(lds + GL_GZ); LAS float* W2 = (LAS float*)(lds + GL_W2); LAS float* BI = (LAS float*)(lds + GL_BI); LAS float* Gm = (LAS float*)(lds + GL_G);
    for (int i = tid; i < 1024; i += 512) { const int s = i >> 4, r = i & 15; GZ[i] = bf2f(PROJ[(size_t)(base + s) * IN0P + C_GF + dir * 16 + r]); }
    for (int i = tid; i < 2048; i += 512) { const int r = i >> 7, k = i & 127; W2[i] = gw2[(dir * 16 + r) * 512 + head * 128 + k]; }
    if (tid < 128) BI[tid] = gb[dir * 512 + head * 128 + tid];
    __syncthreads();
    for (int i = tid; i < 8192; i += 512) { const int s = i >> 7, k = i & 127; float zz = BI[k];
#pragma unroll
        for (int r = 0; r < 16; ++r) zz += GZ[s * 16 + r] * W2[r * 128 + k];
        Gm[s * GL_GS + k] = log_sigmoid_f(zz) * 0.0625f; }
    __syncthreads();
    {
        LAS float* TOT = GZ; const int k = tid & 127, seg = tid >> 7;
        float v[16];
#pragma unroll
        for (int j = 0; j < 16; ++j) v[j] = Gm[(seg * 16 + j) * GL_GS + k];
        if (dir == 0) {
#pragma unroll
            for (int j = 1; j < 16; ++j) v[j] += v[j - 1];
        } else {
#pragma unroll
            for (int j = 14; j >= 0; --j) v[j] += v[j + 1];
        }
        TOT[seg * 128 + k] = dir == 0 ? v[15] : v[0];
        __syncthreads();
        float off = 0.f;
#pragma unroll
        for (int s2 = 0; s2 < 4; ++s2) { const float t = TOT[s2 * 128 + k]; off += (dir == 0 ? (s2 < seg) : (s2 > seg)) ? t : 0.f; }
#pragma unroll
        for (int j = 0; j < 16; ++j) Gm[(seg * 16 + j) * GL_GS + k] = v[j] + off;
    }
    __syncthreads();
}
__device__ __forceinline__ void gla_phase_a(LAS unsigned char* lds, const bf16_t* __restrict__ PROJ, const float* __restrict__ gw2, const float* __restrict__ gb, float* __restrict__ L, float* __restrict__ Dd, float* __restrict__ BC, int bx, int G, int tid) {
    const int lane = tid & 63, wave = tid >> 6, fr = lane & 15, fq = lane >> 4;
    LAS float* Gm = (LAS float*)(lds + GL_G); LAS bf16_t* KT = (LAS bf16_t*)(lds + 46336); LAS bf16_t* VT = (LAS bf16_t*)(lds + 64768);
    for (int item = bx; item < NITEM; item += G) {
        const int stream = item / NCHUNK, chunk = item % NCHUNK, dir = stream >> 2, head = stream & 3, base = gla_base(dir, chunk), slast = dir == 0 ? 63 : 0;
        u32x4 rk[2], rv[4];
#pragma unroll
        for (int t = 0; t < 2; ++t) { const int i = tid + t * 512, s = i & 63, c8 = (i >> 6) * 8; rk[t] = *(const u32x4*)(PROJ + (size_t)(base + s) * IN0P + C_K + head * 128 + c8); }
#pragma unroll
        for (int t = 0; t < 4; ++t) { const int i = tid + t * 512, s = i & 63, c8 = (i >> 6) * 8; rv[t] = *(const u32x4*)(PROJ + (size_t)(base + s) * IN0P + C_V + head * 256 + c8); }
        gla_gates(lds, PROJ, base, dir, head, gw2, gb, tid);
#pragma unroll
        for (int t = 0; t < 4; ++t) { const int i = tid + t * 512, s = i >> 5, k = (i & 31) * 4;
            *(f32x4*)(BC + (size_t)item * 8192 + s * 128 + k) = (f32x4){Gm[s * GL_GS + k], Gm[s * GL_GS + k + 1], Gm[s * GL_GS + k + 2], Gm[s * GL_GS + k + 3]}; }
#pragma unroll
        for (int t = 0; t < 2; ++t) { const int i = tid + t * 512, s = i & 63, c8 = (i >> 6) * 8;
#pragma unroll
            for (int j = 0; j < 8; ++j) { const int k = c8 + j; const float e = __expf(Gm[slast * GL_GS + k] - Gm[s * GL_GS + k]); KT[k * 72 + s] = (bf16_t)f2bf(bfel(rk[t], j) * e); } }
#pragma unroll
        for (int t = 0; t < 4; ++t) { const int i = tid + t * 512, s = i & 63, c8 = (i >> 6) * 8;
#pragma unroll
            for (int j = 0; j < 8; ++j) VT[(c8 + j) * 72 + s] = (bf16_t)bfraw(rv[t], j); }
        __syncthreads();
        f32x4 acc[2][8];
#pragma unroll
        for (int mi = 0; mi < 2; ++mi)
#pragma unroll
            for (int ni = 0; ni < 8; ++ni) acc[mi][ni] = (f32x4){0.f, 0.f, 0.f, 0.f};
#pragma unroll
        for (int ks = 0; ks < 2; ++ks) {
            bf16x8 a[2], b[8];
#pragma unroll
            for (int mi = 0; mi < 2; ++mi) a[mi] = *(const LAS bf16x8*)(VT + (wave * 32 + mi * 16 + fr) * 72 + ks * 32 + fq * 8);
#pragma unroll
            for (int ni = 0; ni < 8; ++ni) b[ni] = *(const LAS bf16x8*)(KT + (ni * 16 + fr) * 72 + ks * 32 + fq * 8);
#pragma unroll
            for (int mi = 0; mi < 2; ++mi)
#pragma unroll
                for (int ni = 0; ni < 8; ++ni) acc[mi][ni] = __builtin_amdgcn_mfma_f32_16x16x32_bf16(b[ni], a[mi], acc[mi][ni], 0, 0, 0);
        }
        float* Lp = L + (size_t)item * 32768;
#pragma unroll
        for (int mi = 0; mi < 2; ++mi)
#pragma unroll
            for (int ni = 0; ni < 8; ++ni)
                *(f32x4*)(Lp + (wave * 32 + mi * 16 + fr) * 128 + ni * 16 + fq * 4) = acc[mi][ni];
        if (tid < 128) Dd[item * 128 + tid] = __expf(Gm[slast * GL_GS + tid]);
        __syncthreads();
    }
}
__device__ __forceinline__ void gla_phase_b(const float* __restrict__ L, const float* __restrict__ Dd, bf16_t* __restrict__ STB, int gtid, int NT) {
    for (int g = gtid; g < 8 * 8192; g += NT) {
        const int stream = g >> 13, e4 = g & 8191;
        const f32x4* Lp = (const f32x4*)(L + (size_t)stream * NCHUNK * 32768) + e4;
        u32x2* Sp = (u32x2*)(STB + (size_t)stream * NCHUNK * 32768) + e4;
        const f32x4* Dp = (const f32x4*)(Dd + stream * NCHUNK * 128) + (e4 & 31);
        f32x4 s = (f32x4){0.f, 0.f, 0.f, 0.f};
#pragma unroll 1
        for (int c = 0; c < NCHUNK; c += 12) {
            f32x4 l[12], d[12];
#pragma unroll
            for (int j = 0; j < 12; ++j) { l[j] = Lp[(size_t)(c + j) * 8192]; d[j] = Dp[(c + j) * 32]; }
#pragma unroll
            for (int j = 0; j < 12; ++j) { u32x2 w; w.x = pk2(s.x, s.y); w.y = pk2(s.z, s.w); Sp[(size_t)(c + j) * 8192] = w; s = d[j] * s + l[j]; }
        }
    }
}
__device__ __forceinline__ void gla_phase_c(LAS unsigned char* lds, const bf16_t* __restrict__ PROJ, const float* __restrict__ BC, const bf16_t* __restrict__ STB, float* __restrict__ OF, float* __restrict__ OB, int bx, int G, int tid) {
    const int lane = tid & 63, wave = tid >> 6, fr = lane & 15, fq = lane >> 4;
    LAS float* Gm = (LAS float*)(lds + GL_G); LAS bf16_t* P = (LAS bf16_t*)(lds + GL_G);
    LAS bf16_t* QT = (LAS bf16_t*)(lds + 46336); LAS bf16_t* KT2 = (LAS bf16_t*)(lds + 63744); LAS bf16_t* VT = (LAS bf16_t*)(lds + 81152); LAS bf16_t* SB = (LAS bf16_t*)(lds + 99584);
    for (int it2 = bx; it2 < 2 * NITEM; it2 += G) {
        const int item = it2 >> 1, vh = it2 & 1;
        const int stream = item / NCHUNK, chunk = item % NCHUNK, dir = stream >> 2, head = stream & 3, base = gla_base(dir, chunk);
        u32x4 rq[2], rk[2], rv[2], rs[4];
#pragma unroll
        for (int t = 0; t < 2; ++t) { const int i = tid + t * 512, s = i >> 4, c8 = (i & 15) * 8;
            rq[t] = *(const u32x4*)(PROJ + (size_t)(base + s) * IN0P + C_Q + head * 128 + c8); rk[t] = *(const u32x4*)(PROJ + (size_t)(base + s) * IN0P + C_K + head * 128 + c8); }
#pragma unroll
        for (int t = 0; t < 2; ++t) { const int i = tid + t * 512, s = i & 63, c8 = (i >> 6) * 8; rv[t] = *(const u32x4*)(PROJ + (size_t)(base + s) * IN0P + C_V + head * 256 + vh * 128 + c8); }
#pragma unroll
        for (int t = 0; t < 4; ++t) { const int i = tid + t * 512, v = i >> 4, c8 = (i & 15) * 8; rs[t] = *(const u32x4*)(STB + (size_t)item * 32768 + (size_t)(vh * 128 + v) * 128 + c8); }
        f32x4 gq[2][2];
#pragma unroll
        for (int t = 0; t < 2; ++t) { const int i = tid + t * 512, s = i >> 4, c8 = (i & 15) * 8; gq[t][0] = *(const f32x4*)(BC + (size_t)item * 8192 + s * 128 + c8); gq[t][1] = *(const f32x4*)(BC + (size_t)item * 8192 + s * 128 + c8 + 4); }
#pragma unroll
        for (int t = 0; t < 2; ++t) { const int i = tid + t * 512, s = i >> 4, c8 = (i & 15) * 8;
            float qo[8], ko[8];
#pragma unroll
            for (int j = 0; j < 8; ++j) { const float b = gq[t][j >> 2][j & 3]; qo[j] = bfel(rq[t], j) * 0.088388347648318440f * __expf(b); ko[j] = bfel(rk[t], j) * __expf(-b); }
            u32x4 wq, wk; wq.x = pk2(qo[0], qo[1]); wq.y = pk2(qo[2], qo[3]); wq.z = pk2(qo[4], qo[5]); wq.w = pk2(qo[6], qo[7]);
            wk.x = pk2(ko[0], ko[1]); wk.y = pk2(ko[2], ko[3]); wk.z = pk2(ko[4], ko[5]); wk.w = pk2(ko[6], ko[7]);
            *(LAS u32x4*)(QT + s * 136 + c8) = wq; *(LAS u32x4*)(KT2 + s * 136 + c8) = wk; }
#pragma unroll
        for (int t = 0; t < 2; ++t) { const int i = tid + t * 512, s = i & 63, c8 = (i >> 6) * 8;
#pragma unroll
            for (int j = 0; j < 8; ++j) VT[(c8 + j) * 72 + s] = (bf16_t)bfraw(rv[t], j); }
#pragma unroll
        for (int t = 0; t < 4; ++t) { const int i = tid + t * 512, v = i >> 4, c8 = (i & 15) * 8; *(LAS u32x4*)(SB + v * 136 + c8) = rs[t]; }
        __syncthreads();
        {
            const int mt = wave >> 1, nt0 = (wave & 1) * 2;
            f32x4 pa[2] = {(f32x4){0.f, 0.f, 0.f, 0.f}, (f32x4){0.f, 0.f, 0.f, 0.f}};
#pragma unroll
            for (int ks = 0; ks < 4; ++ks) { const bf16x8 a = *(const LAS bf16x8*)(QT + (mt * 16 + fr) * 136 + ks * 32 + fq * 8);
#pragma unroll
                for (int n2 = 0; n2 < 2; ++n2) { const bf16x8 b = *(const LAS bf16x8*)(KT2 + ((nt0 + n2) * 16 + fr) * 136 + ks * 32 + fq * 8); pa[n2] = __builtin_amdgcn_mfma_f32_16x16x32_bf16(a, b, pa[n2], 0, 0, 0); } }
#pragma unroll
            for (int n2 = 0; n2 < 2; ++n2)
#pragma unroll
                for (int j = 0; j < 4; ++j) { const int t = mt * 16 + fq * 4 + j, s = (nt0 + n2) * 16 + fr; const bool keep = dir == 0 ? (s <= t) : (s >= t); P[t * 72 + s] = (bf16_t)f2bf(keep ? pa[n2][j] : 0.f); }
        }
        __syncthreads();
        {
            f32x4 oa[4];
#pragma unroll
            for (int mi = 0; mi < 4; ++mi) oa[mi] = (f32x4){0.f, 0.f, 0.f, 0.f};
#pragma unroll
            for (int ks = 0; ks < 4; ++ks) { const bf16x8 b = *(const LAS bf16x8*)(SB + (wave * 16 + fr) * 136 + ks * 32 + fq * 8);
#pragma unroll
                for (int mi = 0; mi < 4; ++mi) { const bf16x8 a = *(const LAS bf16x8*)(QT + (mi * 16 + fr) * 136 + ks * 32 + fq * 8); oa[mi] = __builtin_amdgcn_mfma_f32_16x16x32_bf16(b, a, oa[mi], 0, 0, 0); } }
#pragma unroll
            for (int ks = 0; ks < 2; ++ks) { const bf16x8 b = *(const LAS bf16x8*)(VT + (wave * 16 + fr) * 72 + ks * 32 + fq * 8);
#pragma unroll
                for (int mi = 0; mi < 4; ++mi) { const bf16x8 a = *(const LAS bf16x8*)(P + (mi * 16 + fr) * 72 + ks * 32 + fq * 8); oa[mi] = __builtin_amdgcn_mfma_f32_16x16x32_bf16(b, a, oa[mi], 0, 0, 0); } }
            float* Od = dir == 0 ? OF : OB;
#pragma unroll
            for (int mi = 0; mi < 4; ++mi) *(f32x4*)(Od + (size_t)(base + mi * 16 + fr) * 1024 + head * 256 + vh * 128 + wave * 16 + fq * 4) = oa[mi];
        }
        __syncthreads();
    }
}

constexpr int NPHASE = 26;
struct Args { const float* in[21]; float* out; unsigned char* ws; int ph_lo, ph_hi; };
__global__ void __launch_bounds__(512, 2) mk_fwd(Args args) {
    extern __shared__ __attribute__((aligned(16))) unsigned char lds_raw[];
    LAS unsigned char* lds = (LAS unsigned char*)lds_raw;
    volatile LAS unsigned* bst = (volatile LAS unsigned*)(lds + LDS_BYTES - 64);
    if (threadIdx.x < 16) bst[threadIdx.x] = 0u;
    __syncthreads();
    const XcdBarrier gbar = xcd_barrier_post((unsigned*)(args.ws + WS_CTL), bst);
    const int wave_s = __builtin_amdgcn_readfirstlane(threadIdx.x >> 6);
    const int lo = args.ph_lo, hi = args.ph_hi;
#define IN(k) (lo <= (k) && (k) < hi)
#define SEAM(k) do { if (IN(k) && IN((k) + 1)) { cooperative_groups::this_grid().sync(); } } while (0)
#define W13T(l, s) ((bf16_t*)(ws + WS_W13 + (size_t)((l) * 2 + (s)) * W13_BYTES))
#define W2T(l, s) ((bf16_t*)(ws + WS_W2 + (size_t)((l) * 2 + (s)) * W2_BYTES))
#define MODP(l, w) (MOD + (size_t)((l) * 2 + (w)) * NMOD)


    enum { OP_PRO, OP_MOD, OP_NORM, OP_G1, OP_G2, OP_INPROJ, OP_GLA_A, OP_GLA_B, OP_GLA_C, OP_READ, OP_OUTPROJ, OP_QKV, OP_ATTN, OP_COMB, OP_FINAL };
#pragma unroll 1
    for (int p = lo, rep = 0; p < hi; ) {
        (void)rep;
        int lane_l; asm volatile("v_mbcnt_lo_u32_b32 %0, -1, 0\n\tv_mbcnt_hi_u32_b32 %0, -1, %0" : "=v"(lane_l));
        int tid_l = wave_s * 64 + lane_l, bx_l = blockIdx.x, G_l = gridDim.x; asm volatile("" : "+v"(tid_l)); asm volatile("" : "+s"(bx_l)); asm volatile("" : "+s"(G_l));
        const int tid = tid_l, lane = tid & 63, wave = __builtin_amdgcn_readfirstlane(tid >> 6);
        const int G = G_l, bx = bx_l, gw = bx * 8 + wave, NGW = G * 8, gtid = bx * 512 + tid, NT = G * 512;
        const __attribute__((address_space(4))) Args* ap = (const __attribute__((address_space(4))) Args*)__builtin_amdgcn_kernarg_segment_ptr(); asm volatile("" : "+s"(ap));
        unsigned char* ws = ap->ws;
        const float* x = ap->in[0]; const float* cvec = ap->in[1]; const float* ctx = ap->in[2]; const float* cctx = ap->in[3];
        const float* ada_w = ap->in[4]; const float* ada_b = ap->in[5]; const float* ffn_w1 = ap->in[6]; const float* ffn_w3 = ap->in[7]; const float* ffn_w2 = ap->in[8];
        const float* gla_w_in = ap->in[9]; const float* gla_gw2 = ap->in[10]; const float* gla_gb = ap->in[11]; const float* gla_nw = ap->in[12];
        const float* pool_w = ap->in[13]; const float* pool_scale = ap->in[14]; const float* mix0_w_out = ap->in[15]; const float* diff_w_qkv = ap->in[16];
        const float* diff_lambda = ap->in[17]; const float* diff_nw = ap->in[18]; const float* diff_w_out = ap->in[19]; const float* final_nw = ap->in[20];
        float* MOD = (float*)(ws + WS_MOD); float* ADAP = (float*)(ws + WS_ADAP); float* ROPEC = (float*)(ws + WS_ROPEC); float* ROPES = (float*)(ws + WS_ROPES);
        bf16_t* POOLWT = (bf16_t*)(ws + WS_POOLW); float* GLAD = (float*)(ws + WS_GLAD);
        bf16_t* WINT = (bf16_t*)(ws + WS_WIN); bf16_t* WOUT0 = (bf16_t*)(ws + WS_WOUT0); bf16_t* WQKV = (bf16_t*)(ws + WS_WQKV); bf16_t* WOUT1 = (bf16_t*)(ws + WS_WOUT1);
        float* H = (float*)(ws + WS_H); bf16_t* Z = (bf16_t*)(ws + WS_Z); bf16_t* U = (bf16_t*)(ws + WS_U); bf16_t* PROJ = (bf16_t*)(ws + WS_PROJ); bf16_t* A2 = (bf16_t*)(ws + WS_A2);
        bf16_t* POOLED = (bf16_t*)(ws + WS_POOLED); float* LST = (float*)(ws + WS_L); bf16_t* STB = (bf16_t*)(ws + WS_STB); float* OF = (float*)(ws + WS_OF); float* OB = (float*)(ws + WS_OB);
        float* ATT0 = (float*)(ws + WS_ATT0); float* ATT1 = (float*)(ws + WS_ATT1); float* PARTB = (float*)(ws + WS_PART); float* BCUM = (float*)(ws + WS_BCUM);
        int op, layer = 0, slot = 0, half = 0, M = MROWS;
        if (p == 0) op = OP_PRO; else if (p == 1) op = OP_MOD; else if (p == NPHASE - 1) op = OP_FINAL;
        else if (p < 15) { const int q = p - 2;
            op = q == 0 ? OP_NORM : q == 1 ? OP_G1 : q == 2 ? OP_G2 : q == 3 ? OP_NORM : q == 4 ? OP_INPROJ : q == 5 ? OP_GLA_A : q == 6 ? OP_GLA_B : q == 7 ? OP_GLA_C : q == 8 ? OP_READ : q == 9 ? OP_OUTPROJ : q == 10 ? OP_NORM : q == 11 ? OP_G1 : OP_G2;
            slot = q == 3 ? 3 : q == 10 ? 6 : 0; half = q >= 10 ? 1 : 0; }
        else { const int q = p - 15; layer = 1;
            op = q == 0 ? OP_NORM : q == 1 ? OP_G1 : q == 2 ? OP_G2 : q == 3 ? OP_NORM : q == 4 ? OP_QKV : q == 5 ? OP_ATTN : q == 6 ? OP_OUTPROJ : q == 7 ? OP_NORM : q == 8 ? OP_G1 : OP_G2;
            slot = q == 3 ? 3 : q == 7 ? 6 : 0; half = q >= 7 ? 1 : 0; if (q >= 6) M = SEQ; }
        const float* ml = MODP(layer, 0); const float* mc = MODP(layer, 1);

        if (op == OP_PRO) {
            LAS float* SC = (LAS float*)lds;
            for (int i = tid; i < DM; i += 512) { SC[i] = silu_x(cvec[i]); SC[DM + i] = silu_x(cctx[i]); }
            __syncthreads();
            for (int it = gw; it < 2 * ADA_KC * 72; it += NGW) {
                const int l = it / (ADA_KC * 72), r = it % (ADA_KC * 72), kc = r / 72, nb = r % 72, n = nb * 256 + lane * 4;
                const float* w = ada_w + ((size_t)l * DM + kc * 128) * NMOD + n;
                f32x4 a0 = (f32x4){0.f, 0.f, 0.f, 0.f}, a1 = a0;
#pragma unroll 8
                for (int k = 0; k < 128; ++k) { const f32x4 wv = *(const f32x4*)(w + (size_t)k * NMOD); a0 = a0 + wv * SC[kc * 128 + k]; a1 = a1 + wv * SC[DM + kc * 128 + k]; }
                *(f32x4*)(ADAP + ((size_t)(l * ADA_KC + kc) * 2 + 0) * NMOD + n) = a0;
                *(f32x4*)(ADAP + ((size_t)(l * ADA_KC + kc) * 2 + 1) * NMOD + n) = a1;
            }
            LAS float* scr = (LAS float*)(lds + 16384 + wave * 8704);
            constexpr int I_F13 = (DM / 64) * (DFF / 32), I_F2 = (DFF / 64) * (DM / 32), I_IN = (DM / 64) * (IN0 / 32), I_O = (DM / 64) * (DM / 32), I_QKV = (DM / 64) * (QKVN / 32), I_PW = (256 / 64) * (256 / 32);
            constexpr int NIT = 4 * (2 * I_F13 + I_F2) + I_IN + 2 * I_O + I_QKV + 4 * I_PW;
#pragma unroll 1
            for (int it = gw; it < NIT; it += NGW) {
                int r = it;
                if (r < 4 * (2 * I_F13 + I_F2)) { const int ls = r / (2 * I_F13 + I_F2); r -= ls * (2 * I_F13 + I_F2);
                    if (r < I_F13) { transpose_item<1>(ffn_w1 + (size_t)ls * DM * DFF, DM, DFF, W13T(0, 0) + (size_t)ls * (W13_BYTES / 2), 0, scr, r, lane); continue; } r -= I_F13;
                    if (r < I_F13) { transpose_item<1>(ffn_w3 + (size_t)ls * DM * DFF, DM, DFF, W13T(0, 0) + (size_t)ls * (W13_BYTES / 2), 1, scr, r, lane); continue; } r -= I_F13;
                    transpose_item<0>(ffn_w2 + (size_t)ls * DFF * DM, DFF, DM, W2T(0, 0) + (size_t)ls * (W2_BYTES / 2), 0, scr, r, lane); continue; }
                r -= 4 * (2 * I_F13 + I_F2);
                if (r < I_IN) { transpose_item<0>(gla_w_in, DM, IN0, WINT, 0, scr, r, lane); continue; } r -= I_IN;
                if (r < I_O) { transpose_item<0>(mix0_w_out, DM, DM, WOUT0, 0, scr, r, lane); continue; } r -= I_O;
                if (r < I_O) { transpose_item<0>(diff_w_out, DM, DM, WOUT1, 0, scr, r, lane); continue; } r -= I_O;
                if (r < I_QKV) { transpose_item<2>(diff_w_qkv, DM, QKVN, WQKV, 0, scr, r, lane); continue; } r -= I_QKV;
                { const int g = r / I_PW; transpose_item<0>(pool_w + (size_t)g * 65536, 256, 256, POOLWT + (size_t)g * 65536, 0, scr, r % I_PW, lane); }
            }
            for (int i = gtid; i < (IN0P - IN0) * DM / 8; i += NT) ((u32x4*)(WINT + (size_t)IN0 * DM))[i] = (u32x4){0u, 0u, 0u, 0u};
            for (int i = gtid; i < SEQ * 64; i += NT) { const int t = i >> 6, j = i & 63; const int pos = j < 32 ? (t >> 6) : (t & 63);
                const float ang = (float)pos * exp2f(-(float)(j & 31) * (13.287712379549449f / 32.0f)); ROPEC[i] = __cosf(ang); ROPES[i] = __sinf(ang); }
            __syncthreads();
        } else if (op == OP_MOD) {
            for (int i = gtid; i < 2 * 2 * NMOD; i += NT) { const int l = i / (2 * NMOD), r = i % (2 * NMOD), w = r / NMOD, n = r % NMOD;
                float a = ada_b[l * NMOD + n];
                for (int kc = 0; kc < ADA_KC; ++kc) a += ADAP[((size_t)(l * ADA_KC + kc) * 2 + w) * NMOD + n];
                MOD[i] = a; }
        } else if (op == OP_NORM) {
            const bool first = (p == 2);
            const bool lazy = (G == 256);
            norm_mod_phase(first ? x : H, (first || (lazy && p == 5)) ? ctx : H + (size_t)SEQ * DM, (const bf16_t*)nullptr, H, first && !lazy, first && !lazy, PARTB, (first || G != 256) ? 0 : (slot == 6 ? 4 : 11), Z, ml, mc, slot, M, gw, NGW, lane, lds, bx, G, wave);
        } else if (op == OP_G1) {
            pg8::Gemm g{Z, W13T(layer, half), M, 2 * DFF, DM}; pg8::StaticOrder S; S.init(M, 2 * DFF, G, bx, DM); pg8::EpiSwiglu E{U, DFF};
            pg8::gemm_phase<pg8::EpiSwiglu, pg8::StaticOrder, true, true>(lds, g, S, E, tid);
        } else if (op == OP_G2 || op == OP_OUTPROJ) {
            const bool ffn = op == OP_G2;
            const bf16_t* Ap = ffn ? U : A2; const bf16_t* Bp = ffn ? W2T(layer, half) : (layer == 0 ? WOUT0 : WOUT1);
            const int K = ffn ? DFF : DM, gs = ffn ? (half ? 8 : 2) : 5;
            pg8::Gemm g{Ap, Bp, M, DM, K}; pg8::ResidOrder S; S.init(M, DM, K, G, bx); float cf = ffn ? 0.5f : 1.0f;
#ifdef PROBE_MASK
            if (((PROBE_MASK >> op) & 1) && rep == 0) cf = 0.f;
#endif
            pg8::EpiResid E{H, (G == 256 && p == 4) ? x : (const float*)H, ml + gs * DM, mc + gs * DM, cf, DM, S.split, PARTB};
            pg8::gemm_phase<pg8::EpiResid, pg8::ResidOrder, true, true>(lds, g, S, E, tid);
        } else if (op == OP_INPROJ || op == OP_GLA_B) {
            if (op == OP_GLA_B) gla_phase_b(LST, GLAD, STB, gtid, NT);
            {
                const bool ip = op == OP_INPROJ;
                pg8::Gemm g{ip ? Z : POOLED, ip ? WINT : POOLWT, ip ? MROWS : 4 * MROWS, ip ? IN0P : 256, ip ? DM : 256};
                pg8::StaticOrder S; S.init(ip ? MROWS : 4 * MROWS, ip ? IN0P : 256, G, bx, ip ? DM : 256, ip ? 0 : 33);
                pg8::EpiStore E{ip ? PROJ : A2 + 1024, ip ? IN0P : DM, ip ? (const float*)nullptr : pool_scale, ip ? 0 : 33};
                pg8::gemm_phase<pg8::EpiStore, pg8::StaticOrder, true, true>(lds, g, S, E, tid);
            }
        } else if (op == OP_GLA_A) {
            gla_phase_a(lds, PROJ, gla_gw2, gla_gb, LST, GLAD, BCUM, bx, G, tid);
            if (G == 256) { if (bx >= 32) pool_phase(PROJ, POOLED, (bx - 32) * 512 + tid, (G - 32) * 512); } else pool_phase(PROJ, POOLED, gtid, NT);
        } else if (op == OP_GLA_C) {
            gla_phase_c(lds, PROJ, BCUM, STB, OF, OB, bx, G, tid);
        } else if (op == OP_READ) {
            gla_readout_phase(OF, OB, PROJ, gla_nw, A2, gw, NGW, lane);
        } else if (op == OP_QKV) {
            pg8::Gemm g{Z, WQKV, MROWS, QKVN, DM}; pg8::StaticOrder S; S.init(MROWS, QKVN, G, bx, DM); pg8::EpiQkv E{PROJ, QKVN, ROPEC, ROPES};
            pg8::gemm_phase<pg8::EpiQkv, pg8::StaticOrder, true, true>(lds, g, S, E, tid);
        } else if (op == OP_ATTN) {
            const float lam_init = 0.8f - 0.6f * 0.74081822068171786607f;
            const float* lp = diff_lambda;
            const float s01 = wave_sum(lp[lane] * lp[128 + lane] + lp[64 + lane] * lp[192 + lane]);
            const float s23 = wave_sum(lp[256 + lane] * lp[384 + lane] + lp[320 + lane] * lp[448 + lane]);
            const float lam = expf(s01) - expf(s23) + lam_init;
#pragma unroll 1
            for (int un = bx; un < 256; un += G) {
                const int h = un & 7, qb = un >> 3;
#pragma unroll 1
                for (int c = 0; c < 2; ++c) {
                    const att::bf16* Qp = (const att::bf16*)PROJ + (size_t)(qb * 256) * QKVN + h * 256 + c * 128;
                    const att::bf16* Kp = (const att::bf16*)PROJ + DM + h * 256 + c * 128;
                    const att::bf16* Vp = (const att::bf16*)PROJ + 2 * DM + h * 256;
                    float* Op = ATT0 + (size_t)(qb * 256) * DM + h * 256;
                    att::attn_dv256_body(Qp, Kp, Vp, Op, MROWS, (char*)lds_raw, lds, tid, c, lam, 1.0f - lam_init, diff_nw, A2 + (size_t)(qb * 256) * DM + h * 256);
                    __syncthreads();
                }
            }
        } else if (op == OP_COMB) {
            diff_combine_phase(ATT0, ATT1, diff_lambda, diff_nw, A2, gw, NGW, lane);
        } else {
            final_norm_phase(H, (const bf16_t*)nullptr, ap->out, final_nw, gw, NGW, lane);
        }
#ifdef PROBE_MASK
        if (rep == 0 && ((PROBE_MASK >> op) & 1)) { rep = 1; xcd_barrier(gbar); continue; }
        rep = 0;
#endif
        ++p;
        if (p < hi) { if (p == 1) cooperative_groups::this_grid().sync(); else xcd_barrier(gbar); }
    }
#undef IN
#undef SEAM
}

extern "C" void kernel_launch(void* const* d_in, const int* in_sizes, int n_in, void* d_out, int out_size, void* d_ws, size_t ws_size, hipStream_t stream) {
    static int grid = 0;
    if (grid == 0) {
        if (n_in != 21 || out_size != SEQ * DM || ws_size < WS_END) { fprintf(stderr, "kernel_launch: unexpected shapes: n_in %d out %d ws %zu (need %zu)\n", n_in, out_size, ws_size, (size_t)WS_END); grid = -1; return; }
        int dev = 0, cus = 0, per_cu = 0;
        if (hipGetDevice(&dev) != hipSuccess || hipDeviceGetAttribute(&cus, hipDeviceAttributeMultiprocessorCount, dev) != hipSuccess) { grid = -1; return; }
        if (hipFuncSetAttribute((const void*)mk_fwd, hipFuncAttributeMaxDynamicSharedMemorySize, LDS_BYTES) != hipSuccess) { fprintf(stderr, "kernel_launch: hipFuncSetAttribute failed\n"); grid = -1; return; }
        if (hipOccupancyMaxActiveBlocksPerMultiprocessor(&per_cu, (const void*)mk_fwd, 512, LDS_BYTES) != hipSuccess || per_cu < 1) { fprintf(stderr, "kernel_launch: occupancy query gave %d\n", per_cu); per_cu = 1; }
        (void)hipGetLastError();
        grid = cus * 1;
    }
    if (grid < 0) return;
    if (hipMemsetAsync((char*)d_ws + WS_CTL, 0, CTL_ZERO_BYTES, stream) != hipSuccess) { fprintf(stderr, "kernel_launch: memset of the barrier words failed\n"); return; }
    Args a{};
    for (int i = 0; i < 21; ++i) a.in[i] = (const float*)d_in[i];
    a.out = (float*)d_out; a.ws = (unsigned char*)d_ws;
#if MK_SPLIT
    for (int p = 0; p < NPHASE; ++p) { a.ph_lo = p; a.ph_hi = p + 1; hipLaunchKernelGGL(mk_fwd, dim3(grid), dim3(512), LDS_BYTES, stream, a); }
#else
    a.ph_lo = 0; a.ph_hi = NPHASE;
    void* kargs[] = {&a};
    hipError_t e = hipLaunchCooperativeKernel((const void*)mk_fwd, dim3(grid), dim3(512), kargs, LDS_BYTES, stream);
    if (e != hipSuccess) fprintf(stderr, "kernel_launch: cooperative launch failed: %s (grid %d)\n", hipGetErrorString(e), grid);
#endif
    const hipError_t le = hipPeekAtLastError();
    if (le != hipSuccess) fprintf(stderr, "kernel_launch: launch error %s\n", hipGetErrorName(le));
}
```

```cpp
#include <hip/hip_runtime.h>
#include <hip/hip_bf16.h>
#include <hip/hip_cooperative_groups.h>
#include <cstdio>
#include <cstdint>
#include <cmath>
namespace pg8 {
#define PG8_LAS __attribute__((address_space(3)))
typedef unsigned short bf16_t;
typedef short bf16x8 __attribute__((ext_vector_type(8)));
typedef float f32x4 __attribute__((ext_vector_type(4)));
typedef unsigned u32x4 __attribute__((ext_vector_type(4)));
constexpr int BM = 256, BK = 64, HALF = 128, HTB = HALF * BK * 2  , STAGE_BYTES = 8 * HTB, NXCD = 8, WGM = 8;

__host__ __device__ __forceinline__ int lds_byte(int r, int c) { const int st = (r >> 4) * 2 + (c >> 5), rr = r & 15, cc = c & 31, ob = rr * 64 + cc * 2; return st * 1024 + (ob ^ (((ob >> 9) & 1) << 5)); }
__host__ __device__ __forceinline__ void stage_rc(int b, int& R, int& C) { const int st = b / 1024, sb = b % 1024, swz = sb ^ (((sb >> 9) & 1) << 5); R = (st >> 1) * 16 + swz / 64; C = (st & 1) * 32 + (swz % 64) / 2; }
__host__ __device__ __forceinline__ int perm32(int rho) { const int n = rho >> 4, i = rho & 15; return 8 * (i >> 2) + 4 * n + (i & 3); }

struct Unit { int pm, pn, kt0, nkt; };
struct Gemm { const bf16_t* A; const bf16_t* Bt; int M, N, K; };

struct StaticOrder {
    int nM, nN, nwg, G, c, nkt_full, grp;
    __host__ __device__ void init(int M, int N, int G_, int c_, int K_, int grp_ = 0) { nM = M / BM; nN = N / BM; nwg = nM * nN; G = G_; c = c_; nkt_full = K_ / BK; grp = grp_; }
    __host__ __device__ bool next(int i, Unit& u) const {
        const long L = (long)i * G + c; if (L >= nwg) return false;
        int wgid = (int)L; { const int q = nwg / NXCD, r = nwg % NXCD, xcd = wgid % NXCD, off = wgid / NXCD; wgid = (xcd < r ? xcd * (q + 1) : r * (q + 1) + (xcd - r) * q) + off; }
        const int nig = WGM * nN, gid = wgid / nig, fm = gid * WGM, gsz = (nM - fm) < WGM ? (nM - fm) : WGM;
        u.pm = fm + ((wgid % nig) % gsz); u.pn = (wgid % nig) / gsz; u.kt0 = 0; u.nkt = nkt_full; if (grp) u.pn = u.pm / grp; return true;
    }
    __device__ __forceinline__ void a_ready(const Unit&) const {}
    __device__ __forceinline__ void done(const Unit&) const {}
};

__device__ __forceinline__ unsigned cvt_pk_bf16(float lo, float hi) { unsigned r; asm volatile("v_cvt_pk_bf16_f32 %0, %1, %2" : "=v"(r) : "v"(lo), "v"(hi)); return r; }
typedef float f32x2 __attribute__((ext_vector_type(2)));
__device__ __forceinline__ f32x2 gelu_pk(f32x2 v) {
    const f32x2 av = __builtin_elementwise_abs(v), d = av * 0.2316418882f + 1.0f;
    f32x2 t; t.x = __builtin_amdgcn_rcpf(d.x); t.y = __builtin_amdgcn_rcpf(d.y);
    f32x2 q = t * 0.5307027145f + (-0.7265760135f); q = q * t + 0.7107068705f; q = q * t + (-0.142248368f); q = q * t + 0.127414796f; q = q * t;
    const f32x2 s = (v * v) * (-0.72134752044f);
    f32x2 e; e.x = __builtin_amdgcn_exp2f(s.x); e.y = __builtin_amdgcn_exp2f(s.y);
    const f32x2 m = v * (q * e), r = v - m;
    f32x2 o; o.x = v.x < 0.f ? m.x : r.x; o.y = v.y < 0.f ? m.y : r.y; return o;
}

template <int ACT  > struct EpiBf16 {
    static constexpr bool PERM = true, AFTER_DRAIN = false; static_assert(ACT == 0 || ACT == 1, "EpiBf16: ACT is 0 (none) or 1 (gelu_pk)");
    bf16_t* O; int ldc; const float* bias; int split_cols; size_t split_stride; float scale0;
    __device__ __forceinline__ void operator()(const f32x4 (&acc)[2][2][4][2], const Unit& u, int wr, int wc, int fr, int fq) const {
        const int row0 = u.pm * BM + wr * 64 + fr; int colt = u.pn * BM; bf16_t* base = O;
        float sc = 1.f; if (split_cols) { const int t = colt / split_cols; base += (size_t)t * split_stride; colt -= t * split_cols; if (t == 0) sc = scale0; }
        const int col0 = colt + wc * 32 + 8 * fq, bcol0 = u.pn * BM + wc * 32 + 8 * fq;
        f32x4 bv[2][2];
#pragma unroll
        for (int bj = 0; bj < 2; ++bj)
#pragma unroll
            for (int n = 0; n < 2; ++n) bv[bj][n] = bias ? *(const f32x4*)(bias + bcol0 + bj * HALF + 4 * n) : (f32x4){0.f, 0.f, 0.f, 0.f};
#pragma unroll
        for (int ai = 0; ai < 2; ++ai)
#pragma unroll
            for (int m = 0; m < 4; ++m) { bf16_t* rowp = base + (size_t)(row0 + ai * HALF + m * 16) * ldc + col0;
#pragma unroll
                for (int bj = 0; bj < 2; ++bj) { f32x4 v0 = acc[ai][bj][m][0] + bv[bj][0], v1 = acc[ai][bj][m][1] + bv[bj][1];
                    if (ACT == 1) { f32x2 a = gelu_pk((f32x2){v0[0], v0[1]}), b = gelu_pk((f32x2){v0[2], v0[3]}), c = gelu_pk((f32x2){v1[0], v1[1]}), d = gelu_pk((f32x2){v1[2], v1[3]});
                        v0 = (f32x4){a.x, a.y, b.x, b.y}; v1 = (f32x4){c.x, c.y, d.x, d.y}; }
                    v0 = v0 * sc; v1 = v1 * sc; u32x4 w; w.x = cvt_pk_bf16(v0[0], v0[1]); w.y = cvt_pk_bf16(v0[2], v0[3]); w.z = cvt_pk_bf16(v1[0], v1[1]); w.w = cvt_pk_bf16(v1[2], v1[3]);
                    *(u32x4*)(rowp + bj * HALF) = w; } }
    }
};

__device__ __forceinline__ float silu_f(float x) { return x * __builtin_amdgcn_rcpf(1.0f + __expf(-x)); }
struct EpiSwiglu {
    static constexpr bool PERM = true, AFTER_DRAIN = false;
    bf16_t* U; int ldc;
    __device__ __forceinline__ void operator()(const f32x4 (&acc)[2][2][4][2], const Unit& u, int wr, int wc, int fr, int fq) const {
        const int row0 = u.pm * BM + wr * 64 + fr; const int col0 = u.pn * HALF + wc * 32 + 8 * fq;
#pragma unroll
        for (int ai = 0; ai < 2; ++ai)
#pragma unroll
            for (int m = 0; m < 4; ++m) { bf16_t* rowp = U + (size_t)(row0 + ai * HALF + m * 16) * ldc + col0;
                const f32x4 a0 = acc[ai][0][m][0], a1 = acc[ai][0][m][1], b0 = acc[ai][1][m][0], b1 = acc[ai][1][m][1];
                f32x4 v0, v1;
#pragma unroll
                for (int i = 0; i < 4; ++i) { v0[i] = silu_f(a0[i]) * b0[i]; v1[i] = silu_f(a1[i]) * b1[i]; }
                u32x4 w; w.x = cvt_pk_bf16(v0[0], v0[1]); w.y = cvt_pk_bf16(v0[2], v0[3]); w.z = cvt_pk_bf16(v1[0], v1[1]); w.w = cvt_pk_bf16(v1[2], v1[3]);
                *(u32x4*)rowp = w; }
    }
};
struct ResidOrder {
    StaticOrder base; int c, nsplit, split;
    __device__ void init(int M, int N, int K, int G_, int c_) { split = (G_ == 256 && M == 8448 && N == 2048) ? 1 : 0; base.init(split ? 8192 : M, N, G_, c_, K); c = c_; nsplit = (K / BK) / 8; }
    __device__ bool next(int i, Unit& u) const {
        if (!split) return base.next(i, u);
        if (i == 0) return base.next(0, u);
        if (i == 1 && c < 8 * nsplit) { u.pm = 32; u.pn = c & 7; u.nkt = 8; u.kt0 = (c >> 3) * 8; return true; }
        return false;
    }
    __device__ __forceinline__ void a_ready(const Unit&) const {}
    __device__ __forceinline__ void done(const Unit&) const {}
};
struct EpiResid {
    static constexpr bool PERM = false, AFTER_DRAIN = false;
    float* H; const float* Hin; const float* gate_lat; const float* gate_ctx; float coef; int ldc; int ctx_atomic; float* PART;
    __device__ __forceinline__ void operator()(const f32x4 (&acc)[2][2][4][2], const Unit& u, int wr, int wc, int fr, int fq) const {
        const float* gate = (u.pm >= 32) ? gate_ctx : gate_lat;
        const int row0 = u.pm * BM + wr * 64 + fr; const int col0 = u.pn * BM + wc * 32 + 4 * fq;
        f32x4 gv[2][2];
#pragma unroll
        for (int bj = 0; bj < 2; ++bj)
#pragma unroll
            for (int n = 0; n < 2; ++n) gv[bj][n] = *(const f32x4*)(gate + col0 + bj * HALF + n * 16) * coef;
        if (ctx_atomic && u.pm >= 32) {
            float* Pb = PART + ((size_t)(u.kt0 >> 3) * 256 + (size_t)(wr * 64 + fr)) * 2048 + col0;
#pragma unroll
            for (int ai = 0; ai < 2; ++ai)
#pragma unroll
                for (int m = 0; m < 4; ++m) { float* rowp = Pb + (size_t)(ai * HALF + m * 16) * 2048;
#pragma unroll
                    for (int bj = 0; bj < 2; ++bj)
#pragma unroll
                        for (int n = 0; n < 2; ++n) *(f32x4*)(rowp + bj * HALF + n * 16) = gv[bj][n] * acc[ai][bj][m][n]; }
        } else {
#pragma unroll
            for (int ai = 0; ai < 2; ++ai)
#pragma unroll
                for (int mp = 0; mp < 2; ++mp) {
                    f32x4 hv[2][2][2];
#pragma unroll
                    for (int m2 = 0; m2 < 2; ++m2)
#pragma unroll
                        for (int bj = 0; bj < 2; ++bj)
#pragma unroll
                            for (int n = 0; n < 2; ++n) hv[m2][bj][n] = *(const f32x4*)(Hin + (size_t)(row0 + ai * HALF + (2 * mp + m2) * 16) * ldc + col0 + bj * HALF + n * 16);
#pragma unroll
                    for (int m2 = 0; m2 < 2; ++m2)
#pragma unroll
                        for (int bj = 0; bj < 2; ++bj)
#pragma unroll
                            for (int n = 0; n < 2; ++n) *(f32x4*)(H + (size_t)(row0 + ai * HALF + (2 * mp + m2) * 16) * ldc + col0 + bj * HALF + n * 16) = hv[m2][bj][n] + gv[bj][n] * acc[ai][bj][2 * mp + m2][n];
                    asm volatile("" ::: "memory");
                }
        }
    }
};
struct EpiStore {
    static constexpr bool PERM = true, AFTER_DRAIN = false;
    bf16_t* O; int ldc; const float* scale; int grp;
    __device__ __forceinline__ void operator()(const f32x4 (&acc)[2][2][4][2], const Unit& u, int wr, int wc, int fr, int fq) const {
        const int row0 = (grp ? u.pm - u.pn * grp : u.pm) * BM + wr * 64 + fr; const int col0 = u.pn * BM + wc * 32 + 8 * fq;
        f32x4 sv[2][2];
#pragma unroll
        for (int bj = 0; bj < 2; ++bj)
#pragma unroll
            for (int n = 0; n < 2; ++n) sv[bj][n] = scale ? *(const f32x4*)(scale + col0 + bj * HALF + 4 * n) : (f32x4){1.f, 1.f, 1.f, 1.f};
#pragma unroll
        for (int ai = 0; ai < 2; ++ai)
#pragma unroll
            for (int m = 0; m < 4; ++m) { bf16_t* rowp = O + (size_t)(row0 + ai * HALF + m * 16) * ldc + col0;
#pragma unroll
                for (int bj = 0; bj < 2; ++bj) { const f32x4 v0 = acc[ai][bj][m][0] * sv[bj][0], v1 = acc[ai][bj][m][1] * sv[bj][1];
                    u32x4 w; w.x = cvt_pk_bf16(v0[0], v0[1]); w.y = cvt_pk_bf16(v0[2], v0[3]); w.z = cvt_pk_bf16(v1[0], v1[1]); w.w = cvt_pk_bf16(v1[2], v1[3]);
                    *(u32x4*)(rowp + bj * HALF) = w; } }
    }
};
struct EpiQkv {
    static constexpr bool PERM = true, AFTER_DRAIN = false;
    bf16_t* O; int ldc; const float* rc; const float* rs;
    __device__ __forceinline__ void operator()(const f32x4 (&acc)[2][2][4][2], const Unit& u, int wr, int wc, int fr, int fq) const {
        typedef unsigned u32x2v __attribute__((ext_vector_type(2)));
        const int row0 = u.pm * BM + wr * 64 + fr;
        if (u.pn >= 16) {
            const int col0 = u.pn * BM + wc * 32 + 8 * fq;
#pragma unroll
            for (int ai = 0; ai < 2; ++ai)
#pragma unroll
                for (int m = 0; m < 4; ++m) { bf16_t* rowp = O + (size_t)(row0 + ai * HALF + m * 16) * ldc + col0;
#pragma unroll
                    for (int bj = 0; bj < 2; ++bj) { const f32x4 v0 = acc[ai][bj][m][0], v1 = acc[ai][bj][m][1];
                        u32x4 w; w.x = cvt_pk_bf16(v0[0], v0[1]); w.y = cvt_pk_bf16(v0[2], v0[3]); w.z = cvt_pk_bf16(v1[0], v1[1]); w.w = cvt_pk_bf16(v1[2], v1[3]);
                        *(u32x4*)(rowp + bj * HALF) = w; } }
        } else {
            const int q4 = 4 * (4 * wc + fq);
            const bool rot = u.pm < 32;
#pragma unroll
            for (int ai = 0; ai < 2; ++ai)
#pragma unroll
                for (int m = 0; m < 4; ++m) { const int row = row0 + ai * HALF + m * 16;
                    f32x4 c = (f32x4){1.f, 1.f, 1.f, 1.f}, s = (f32x4){0.f, 0.f, 0.f, 0.f};
                    if (rot) { c = *(const f32x4*)(rc + (size_t)row * 64 + q4); s = *(const f32x4*)(rs + (size_t)row * 64 + q4); }
                    bf16_t* rowp = O + (size_t)row * ldc + u.pn * BM + q4;
#pragma unroll
                    for (int bj = 0; bj < 2; ++bj) { const f32x4 x1 = acc[ai][bj][m][0], x2 = acc[ai][bj][m][1];
                        const f32x4 o1 = x1 * c - x2 * s, o2 = x1 * s + x2 * c;
                        u32x2v w1, w2; w1.x = cvt_pk_bf16(o1[0], o1[1]); w1.y = cvt_pk_bf16(o1[2], o1[3]); w2.x = cvt_pk_bf16(o2[0], o2[1]); w2.y = cvt_pk_bf16(o2[2], o2[3]);
                        *(u32x2v*)(rowp + bj * HALF) = w1; *(u32x2v*)(rowp + bj * HALF + 64) = w2; } }
        }
    }
};
template <class Epi, class Sched, bool ALIGN_EPI = false, bool SP2 = false>
__device__ __forceinline__ void gemm_phase(PG8_LAS unsigned char* lds, const Gemm g, const Sched& S, const Epi& E, int tid_in) {
    int tid_l = tid_in; asm volatile("" : "+v"(tid_l)); const int tid = tid_l, wid = __builtin_amdgcn_readfirstlane(tid >> 6), lane = tid & 63, wr = wid >> 2, wc = wid & 3, fr = lane & 15, fq = lane >> 4;
    const int K = g.K; int nt = K / BK;
    unsigned voffA[2], voffB[2];
#pragma unroll
    for (int i = 0; i < 2; ++i) { int R, C; stage_rc(tid * 16 + i * 8192, R, C); const int Rb = Epi::PERM ? ((R & ~31) + perm32(R & 31)) : R;
        voffA[i] = (unsigned)(R * K + C) * 2u; voffB[i] = (unsigned)(Rb * K + C) * 2u; }
    const size_t kstep = (size_t)(BK * 2);
    const size_t hstep = (size_t)HALF * K * 2;
    const size_t tstep = 2 * hstep;
    const unsigned ldsw = (unsigned)wid * 1024u;
    const int aoff = lds_byte(wr * 64 + fr, fq * 8), boff = lds_byte(wc * 32 + fr, fq * 8);
#define PG8_SA(b, h) (((b) * 2 + (h)) * HTB)
#define PG8_SB(b, h) ((4 + (b) * 2 + (h)) * HTB)
#define PG8_STAGE(bufoff, gbase, voff) do { _Pragma("unroll") for (int _i = 0; _i < 2; ++_i) \
        __builtin_amdgcn_global_load_lds((const unsigned*)((const char*)(gbase) + (voff)[_i]), (PG8_LAS unsigned*)(lds + (bufoff) + ldsw + _i * 8192), 16, 0, 0); } while (0)
#define PG8_LDA(dst, b, h) do { _Pragma("unroll") for (int m = 0; m < 4; ++m) _Pragma("unroll") for (int k = 0; k < 2; ++k) dst[m][k] = *(const PG8_LAS bf16x8*)(lds + PG8_SA(b, h) + aoff + m * 2048 + k * 1024); } while (0)
#define PG8_LDB(dst, b, h) do { _Pragma("unroll") for (int n = 0; n < 2; ++n) _Pragma("unroll") for (int k = 0; k < 2; ++k) dst[n][k] = *(const PG8_LAS bf16x8*)(lds + PG8_SB(b, h) + boff + n * 2048 + k * 1024); } while (0)
#define PG8_MMA(ai, bj, At, Bt) do { __builtin_amdgcn_s_setprio(1); _Pragma("unroll") for (int m = 0; m < 4; ++m) _Pragma("unroll") for (int n = 0; n < 2; ++n) _Pragma("unroll") for (int k = 0; k < 2; ++k) \
        acc[ai][bj][m][n] = __builtin_amdgcn_mfma_f32_16x16x32_bf16(Bt[n][k], At[m][k], acc[ai][bj][m][n], 0, 0, 0); __builtin_amdgcn_s_setprio(0); } while (0)
#define PG8_WAIT_V(n) asm volatile("s_waitcnt vmcnt(" #n ")" ::: "memory")
#define PG8_WAIT_L(n) asm volatile("s_waitcnt lgkmcnt(" #n ")" ::: "memory")
#define PG8_BAR __builtin_amdgcn_s_barrier()
#define PG8_SCHED __builtin_amdgcn_sched_barrier(0)
    Unit cur, nxt; int ui = 0;
    if (!S.next(0, cur)) return;
    f32x4 acc[2][2][4][2];
#pragma unroll
    for (int a = 0; a < 2; ++a)
#pragma unroll
        for (int b = 0; b < 2; ++b)
#pragma unroll
            for (int m = 0; m < 4; ++m)
#pragma unroll
                for (int n = 0; n < 2; ++n) acc[a][b][m][n] = (f32x4){0.f, 0.f, 0.f, 0.f};
    bf16x8 At[4][2], B0[2][2], B1[2][2];
    nt = cur.nkt;
    const char* cA = (const char*)g.A + (size_t)cur.pm * tstep + (size_t)cur.kt0 * (size_t)(BK * 2); const char* cB = (const char*)g.Bt + (size_t)cur.pn * tstep + (size_t)cur.kt0 * (size_t)(BK * 2);
    S.a_ready(cur);
    if constexpr (SP2) {
        PG8_STAGE(PG8_SB(0, 0), cB, voffB); PG8_STAGE(PG8_SB(0, 1), cB + hstep, voffB); PG8_STAGE(PG8_SA(0, 0), cA, voffA); PG8_STAGE(PG8_SA(0, 1), cA + hstep, voffA);
        if (wr == 1) PG8_BAR;
        PG8_WAIT_V(2); PG8_BAR;
        PG8_STAGE(PG8_SB(1, 0), cB + kstep, voffB); PG8_STAGE(PG8_SA(1, 0), cA + kstep, voffA); PG8_STAGE(PG8_SB(1, 1), cB + hstep + kstep, voffB);
        PG8_WAIT_V(6); PG8_BAR;
    } else {
        PG8_STAGE(PG8_SB(0, 0), cB, voffB); PG8_STAGE(PG8_SA(0, 0), cA, voffA); PG8_STAGE(PG8_SB(0, 1), cB + hstep, voffB); PG8_STAGE(PG8_SA(0, 1), cA + hstep, voffA);
        if (wr == 1) PG8_BAR;
        PG8_WAIT_V(4); PG8_BAR;
        PG8_STAGE(PG8_SB(1, 0), cB + kstep, voffB); PG8_STAGE(PG8_SA(1, 0), cA + kstep, voffA); PG8_STAGE(PG8_SB(1, 1), cB + hstep + kstep, voffB);
        PG8_WAIT_V(6); PG8_BAR;
    }
    for (;;) {
        const bool has_next = S.next(ui + 1, nxt);
        const char* nA = has_next ? (const char*)g.A + (size_t)nxt.pm * tstep + (size_t)nxt.kt0 * kstep : cA; const char* nB = has_next ? (const char*)g.Bt + (size_t)nxt.pn * tstep + (size_t)nxt.kt0 * kstep : cB;
        for (int t = 0; t < nt; t += 2) {
            const bool last = (t == nt - 2);
            const char* a1 = cA + (size_t)(t + 1) * kstep;
            const char* a2 = last ? nA : cA + (size_t)(t + 2) * kstep; const char* b2 = last ? nB : cB + (size_t)(t + 2) * kstep;
            const char* a3 = a2 + kstep; const char* b3 = b2 + kstep;
            if (last && has_next) S.a_ready(nxt);
            if constexpr (SP2) {
            PG8_LDB(B0, 0, 0); PG8_LDB(B1, 0, 1); PG8_SCHED; PG8_LDA(At, 0, 0); PG8_STAGE(PG8_SA(1, 1), a1 + hstep, voffA);
            PG8_WAIT_V(8); PG8_WAIT_L(0); PG8_BAR; PG8_MMA(0, 0, At, B0); PG8_MMA(0, 1, At, B1); PG8_BAR; PG8_SCHED;
            PG8_LDA(At, 0, 1); PG8_STAGE(PG8_SB(0, 0), b2, voffB); PG8_STAGE(PG8_SB(0, 1), b2 + hstep, voffB); PG8_STAGE(PG8_SA(0, 0), a2, voffA);
            PG8_WAIT_V(8); PG8_WAIT_L(0); PG8_BAR; PG8_MMA(1, 0, At, B0); PG8_MMA(1, 1, At, B1); PG8_BAR; PG8_SCHED;
            PG8_LDB(B0, 1, 0); PG8_LDB(B1, 1, 1); PG8_SCHED; PG8_LDA(At, 1, 0); PG8_STAGE(PG8_SA(0, 1), a2 + hstep, voffA);
            PG8_WAIT_V(8); PG8_WAIT_L(0); PG8_BAR; PG8_MMA(0, 0, At, B0); PG8_MMA(0, 1, At, B1); PG8_BAR; PG8_SCHED;
            PG8_LDA(At, 1, 1); PG8_STAGE(PG8_SB(1, 0), b3, voffB); PG8_STAGE(PG8_SB(1, 1), b3 + hstep, voffB); PG8_STAGE(PG8_SA(1, 0), a3, voffA);
            PG8_WAIT_V(8); PG8_WAIT_L(0); PG8_BAR; PG8_MMA(1, 0, At, B0); PG8_MMA(1, 1, At, B1); PG8_BAR; PG8_SCHED;
            } else {
            PG8_LDB(B0, 0, 0); PG8_SCHED; PG8_LDA(At, 0, 0); PG8_STAGE(PG8_SA(1, 1), a1 + hstep, voffA);
            PG8_WAIT_L(8); PG8_BAR; PG8_WAIT_L(0); PG8_MMA(0, 0, At, B0); PG8_BAR; PG8_SCHED;
            PG8_LDB(B1, 0, 1); PG8_STAGE(PG8_SB(0, 0), b2, voffB);
            PG8_BAR; PG8_WAIT_L(0); PG8_MMA(0, 1, At, B1); PG8_BAR;
            PG8_LDA(At, 0, 1); PG8_STAGE(PG8_SA(0, 0), a2, voffA);
            PG8_BAR; PG8_WAIT_L(0); PG8_MMA(1, 0, At, B0); PG8_BAR; PG8_SCHED;
            PG8_STAGE(PG8_SB(0, 1), b2 + hstep, voffB);
            PG8_WAIT_V(6); PG8_BAR; PG8_MMA(1, 1, At, B1); PG8_BAR;
            PG8_LDB(B0, 1, 0); PG8_SCHED; PG8_LDA(At, 1, 0); PG8_STAGE(PG8_SA(0, 1), a2 + hstep, voffA);
            PG8_WAIT_L(8); PG8_BAR; PG8_WAIT_L(0); PG8_MMA(0, 0, At, B0); PG8_BAR; PG8_SCHED;
            PG8_LDB(B1, 1, 1); PG8_STAGE(PG8_SB(1, 0), b3, voffB);
            PG8_BAR; PG8_WAIT_L(0); PG8_MMA(0, 1, At, B1); PG8_BAR;
            PG8_LDA(At, 1, 1); PG8_STAGE(PG8_SA(1, 0), a3, voffA);
            PG8_BAR; PG8_WAIT_L(0); PG8_MMA(1, 0, At, B0); PG8_BAR; PG8_SCHED;
            PG8_STAGE(PG8_SB(1, 1), b3 + hstep, voffB);
            PG8_WAIT_V(6); PG8_BAR; PG8_MMA(1, 1, At, B1); PG8_BAR;
            }
        }
        if constexpr (ALIGN_EPI) { if (wr == 0) PG8_BAR; }
        if constexpr (!Epi::AFTER_DRAIN) { E(acc, cur, wr, wc, fr, fq); S.done(cur); }
        if (!has_next) break;
#pragma unroll
        for (int a = 0; a < 2; ++a)
#pragma unroll
            for (int b = 0; b < 2; ++b)
#pragma unroll
                for (int m = 0; m < 4; ++m)
#pragma unroll
                    for (int n = 0; n < 2; ++n) acc[a][b][m][n] = (f32x4){0.f, 0.f, 0.f, 0.f};
        cur = nxt; cA = nA; cB = nB; ++ui; nt = cur.nkt;
        if constexpr (ALIGN_EPI) { if (wr == 1) PG8_BAR; }
    }
    PG8_WAIT_V(0);
    if constexpr (!ALIGN_EPI) { if (wr == 0) PG8_BAR; }
    PG8_BAR;
    if constexpr (Epi::AFTER_DRAIN) { E.fused(acc, cur, wr, wc, fr, fq, lds, wid, lane); S.done(cur); }
#undef PG8_SA
#undef PG8_SB
#undef PG8_STAGE
#undef PG8_LDA
#undef PG8_LDB
#undef PG8_MMA
#undef PG8_WAIT_V
#undef PG8_WAIT_L
#undef PG8_BAR
#undef PG8_SCHED
}
}
namespace att {
using bf16 = __hip_bfloat16;
constexpr int   D = 128, NW = 8, QBLK = 32, KVBLK = 64;
constexpr float SCALE = 0.088388347648318440f;
constexpr float THR = 8.f;
constexpr int SDEPTH = 2;
constexpr int LDQ = 6144, LDK = 6144, LDO = 2048;
constexpr size_t SHM_V = KVBLK * D * 2, SHM_K = KVBLK * D * 2, SHM_ATTN = 2 * SHM_V + 2 * SHM_K + NW * 64 * 4;
using bf16x8 = __attribute__((ext_vector_type(8))) short;
using s16x4  = __attribute__((ext_vector_type(4))) short;
using f32x16 = __attribute__((ext_vector_type(16))) float;
using f32x8  = __attribute__((ext_vector_type(8))) float;
using u32x4  = __attribute__((ext_vector_type(4))) unsigned;
#define KSWZ(row, colB) ((row) * 256 + ((colB) ^ (((row) & 7) << 4)))
#define SBAR() __builtin_amdgcn_sched_barrier(0)
__device__ __forceinline__ int crow(int r, int hi) { return (r & 3) + 8 * (r >> 2) + 4 * hi; }
__device__ __forceinline__ unsigned cvtpk(float lo, float hi) {
  unsigned r; asm volatile("v_cvt_pk_bf16_f32 %0, %1, %2" : "=v"(r) : "v"(lo), "v"(hi)); return r;
}
template <typename TIn> struct Stage;
template <> struct Stage<bf16>  { using T = bf16x8;
  __device__ static __forceinline__ T ld8(const bf16* p) { return *reinterpret_cast<const bf16x8*>(p); }
  __device__ static __forceinline__ bf16x8 tobf(T x) { return x; } };
template <> struct Stage<float> { using T = f32x8;
  __device__ static __forceinline__ T ld8(const float* p) { return *reinterpret_cast<const f32x8*>(p); }
  __device__ static __forceinline__ bf16x8 tobf(T x) {
    u32x4 w = {cvtpk(x[0], x[1]), cvtpk(x[2], x[3]), cvtpk(x[4], x[5]), cvtpk(x[6], x[7])}; return *reinterpret_cast<bf16x8*>(&w); } };

__device__ __forceinline__ void partialSM(f32x16& p0, f32x16& p1, float& m_reg, float& mn, float& alpha) {
  constexpr float C = SCALE * 1.4426950408889634f;
  float pmax = p0[0]; for (int r = 1; r < 16; ++r) pmax = fmaxf(pmax, p0[r]); for (int r = 0; r < 16; ++r) pmax = fmaxf(pmax, p1[r]);
  { auto rr = __builtin_amdgcn_permlane32_swap(__float_as_uint(pmax), __float_as_uint(pmax), false, false);
    pmax = fmaxf(__uint_as_float(rr[0]), __uint_as_float(rr[1])); }
  if (__builtin_expect(__all(pmax - m_reg <= THR / SCALE), 1)) { mn = m_reg; alpha = 1.f; }
  else { mn = fmaxf(m_reg, pmax); alpha = __builtin_amdgcn_exp2f((m_reg - mn) * C); m_reg = mn; }
  float mnC = -mn * C;
  for (int r = 0; r < 16; ++r) p0[r] = fmaf(p0[r], C, mnC); for (int r = 0; r < 16; ++r) p1[r] = fmaf(p1[r], C, mnC);
  for (int r = 0; r < 16; ++r) p0[r] = __builtin_amdgcn_exp2f(p0[r]);
}
__device__ __forceinline__ void finishSM(f32x16& p0, f32x16& p1, float alpha, float& l_reg, bf16x8& pa0, bf16x8& pa1, bf16x8& pa2, bf16x8& pa3) {
  for (int r = 0; r < 16; ++r) p1[r] = __builtin_amdgcn_exp2f(p1[r]);
  float ps = 0; for (int r = 0; r < 16; ++r) ps += p0[r]; for (int r = 0; r < 16; ++r) ps += p1[r];
  { auto rr = __builtin_amdgcn_permlane32_swap(__float_as_uint(ps), __float_as_uint(ps), false, false);
    ps = __uint_as_float(rr[0]) + __uint_as_float(rr[1]); }
  l_reg = l_reg * alpha + ps;
#define PK4(P, BASE, OUT) do { unsigned a0 = cvtpk(P[BASE + 0], P[BASE + 1]), a1 = cvtpk(P[BASE + 2], P[BASE + 3]);   \
    unsigned b0 = cvtpk(P[BASE + 4], P[BASE + 5]), b1 = cvtpk(P[BASE + 6], P[BASE + 7]);                              \
    auto r0 = __builtin_amdgcn_permlane32_swap(a0, b0, false, false); auto r1 = __builtin_amdgcn_permlane32_swap(a1, b1, false, false); \
    u32x4 w = {r0[0], r1[0], r0[1], r1[1]}; OUT = *reinterpret_cast<bf16x8*>(&w); } while (0)
  PK4(p0, 0, pa0); PK4(p0, 8, pa1); PK4(p1, 0, pa2); PK4(p1, 8, pa3);
#undef PK4
}
__device__ __forceinline__ void qkt(f32x16& p0, f32x16& p1, const bf16* Ks, const bf16x8* qr, int r32, int hi) {
  p0 = f32x16{}; p1 = f32x16{};
  for (int d0 = 0; d0 < 8; ++d0) { int cb = (d0 * 16 + hi * 8) * 2;
    bf16x8 b0 = *reinterpret_cast<const bf16x8*>((const char*)Ks + KSWZ(r32, cb));
    bf16x8 b1 = *reinterpret_cast<const bf16x8*>((const char*)Ks + KSWZ(32 + r32, cb));
    p0 = __builtin_amdgcn_mfma_f32_32x32x16_bf16(b0, qr[d0], p0, 0, 0, 0);
    p1 = __builtin_amdgcn_mfma_f32_32x32x16_bf16(b1, qr[d0], p1, 0, 0, 0); }
}
__device__ __forceinline__ int v_st(int k, int c) { const int kk = (k & ~0xC) | ((k & 4) << 1) | ((k & 8) >> 1); return ((kk >> 3) * 4 + (c >> 5)) * 512 + ((kk & 7) * 32 + (c & 31)) * 2; }
__device__ __forceinline__ int v_rd_base(int lane) { return ((lane & 3) << 3) | (((lane >> 2) & 3) << 6) | (((lane >> 4) & 1) << 5) | (((lane >> 5) & 1) << 8); }
constexpr int v_rd_off(int d0, int ks, int half) { return d0 * 512 + ks * 4096 + half * 2048; }
template <int OFF> __device__ __forceinline__ s16x4 tr_read(int vb) {
  s16x4 r; asm volatile("ds_read_b64_tr_b16 %0, %1 offset:%2" : "=&v"(r) : "v"(vb), "i"(OFF) : "memory"); return r;
}
template <int D0> __device__ __forceinline__ void pv_one(f32x16& od, int vb, bf16x8 pa0, bf16x8 pa1, bf16x8 pa2, bf16x8 pa3) {
  const s16x4 l0 = tr_read<v_rd_off(D0, 0, 0)>(vb), h0 = tr_read<v_rd_off(D0, 0, 1)>(vb), l1 = tr_read<v_rd_off(D0, 1, 0)>(vb), h1 = tr_read<v_rd_off(D0, 1, 1)>(vb);
  const s16x4 l2 = tr_read<v_rd_off(D0, 2, 0)>(vb), h2 = tr_read<v_rd_off(D0, 2, 1)>(vb), l3 = tr_read<v_rd_off(D0, 3, 0)>(vb), h3 = tr_read<v_rd_off(D0, 3, 1)>(vb);
  asm volatile("s_waitcnt lgkmcnt(0)" ::: "memory"); SBAR();
#define PK(L, H) (bf16x8){L[0], L[1], L[2], L[3], H[0], H[1], H[2], H[3]}
  od = __builtin_amdgcn_mfma_f32_32x32x16_bf16(pa0, PK(l0, h0), od, 0, 0, 0);
  od = __builtin_amdgcn_mfma_f32_32x32x16_bf16(pa1, PK(l1, h1), od, 0, 0, 0);
  od = __builtin_amdgcn_mfma_f32_32x32x16_bf16(pa2, PK(l2, h2), od, 0, 0, 0);
  od = __builtin_amdgcn_mfma_f32_32x32x16_bf16(pa3, PK(l3, h3), od, 0, 0, 0);
#undef PK
}
__device__ __forceinline__ void pv_d0(f32x16* o, int vb, bf16x8 pa0, bf16x8 pa1, bf16x8 pa2, bf16x8 pa3) {
  pv_one<0>(o[0], vb, pa0, pa1, pa2, pa3); pv_one<1>(o[1], vb, pa0, pa1, pa2, pa3); pv_one<2>(o[2], vb, pa0, pa1, pa2, pa3); pv_one<3>(o[3], vb, pa0, pa1, pa2, pa3);
}

template <typename TQ>
__device__ __forceinline__ void attn_dense_body(const TQ* __restrict__ Qb, const bf16* __restrict__ Kh, const bf16* __restrict__ Vh,
                                                float* __restrict__ Ob, int seq, char* lds, int tid_in) {
  using St = Stage<bf16>; using SQ = Stage<TQ>;
  int tid_l = tid_in; asm volatile("" : "+v"(tid_l)); const int tid = tid_l, wid = tid >> 6, lane = tid & 63, r32 = lane & 31, hi = lane >> 5;
  bf16* V_lds = (bf16*)lds; bf16* K_lds = (bf16*)(lds + 2 * SHM_V);
  float* ws = (float*)(lds + 2 * SHM_V + 2 * SHM_K) + wid * 64; float* li_l = ws; float* al_l = ws + 32;
  float m_reg = -1e30f, l_reg = 0; f32x16 o[4] = {}; bf16x8 qr[8];
  const TQ* Qw = Qb + (long)(wid * QBLK + r32) * LDQ + hi * 8;
#pragma unroll
  for (int d0 = 0; d0 < 8; ++d0) qr[d0] = SQ::tobf(SQ::ld8(Qw + d0 * 16));
  const int sr = tid >> 4, sc = (tid & 15) * 8, vst0 = v_st(sr, sc), vst1 = v_st(32 + sr, sc);
  const int vb0 = (int)(uintptr_t)V_lds + v_rd_base(lane);
  struct { typename St::T vs0, vs1, ks0, ks1; } sr_[SDEPTH];
#define SLOAD(i, k0) do { sr_[i].vs0 = St::ld8(&Vh[(long)((k0) + sr) * LDK + sc]); sr_[i].vs1 = St::ld8(&Vh[(long)((k0) + 32 + sr) * LDK + sc]); \
    sr_[i].ks0 = St::ld8(&Kh[(long)((k0) + sr) * LDK + sc]); sr_[i].ks1 = St::ld8(&Kh[(long)((k0) + 32 + sr) * LDK + sc]); } while (0)
#define SWRITE(b, i) do { *(bf16x8*)((char*)V_lds + (b) * SHM_V + vst0) = St::tobf(sr_[i].vs0);          \
    *(bf16x8*)((char*)V_lds + (b) * SHM_V + vst1) = St::tobf(sr_[i].vs1); int kc = sc * 2;               \
    *(bf16x8*)((char*)K_lds + (b) * SHM_K + KSWZ(sr, kc)) = St::tobf(sr_[i].ks0);                       \
    *(bf16x8*)((char*)K_lds + (b) * SHM_K + KSWZ(32 + sr, kc)) = St::tobf(sr_[i].ks1); } while (0)
#define SWAIT() do { if constexpr (SDEPTH == 2) asm volatile("s_waitcnt vmcnt(4)" ::: "memory"); else asm volatile("s_waitcnt vmcnt(0)" ::: "memory"); } while (0)
#define RESC(a) do { if (__any((a) < 1.f)) { if (hi == 0) al_l[r32] = (a); asm volatile("s_waitcnt lgkmcnt(0)" ::: "memory"); \
    for (int d = 0; d < 4; ++d) for (int r = 0; r < 16; ++r) o[d][r] *= al_l[crow(r, hi)]; } } while (0)
  f32x16 pA0, pA1, pB0, pB1; float mnA, mnB, alA, alB; bf16x8 pa0, pa1, pa2, pa3; const int NT = seq / KVBLK;
  constexpr int SE = 0, SO = SDEPTH - 1;
  SLOAD(SE, 0); asm volatile("s_waitcnt vmcnt(0)" ::: "memory"); SWRITE(0, SE); __syncthreads();
  qkt(pA0, pA1, K_lds, qr, r32, hi); partialSM(pA0, pA1, m_reg, mnA, alA);
  SLOAD(SO, KVBLK); if constexpr (SDEPTH == 2) { if (2 < NT) SLOAD(SE, 2 * KVBLK); }
  SWAIT(); SWRITE(1, SO); __syncthreads();
  for (int j = 1; j + 1 < NT; j += 2) {
    SBAR(); qkt(pB0, pB1, (bf16*)((char*)K_lds + SHM_K), qr, r32, hi);
    finishSM(pA0, pA1, alA, l_reg, pa0, pa1, pa2, pa3); SBAR();
    SLOAD(SO, (j + SDEPTH) * KVBLK); SBAR();
    pv_d0(o, vb0, pa0, pa1, pa2, pa3); partialSM(pB0, pB1, m_reg, mnB, alB);
    __syncthreads(); SWAIT(); SWRITE(0, SE);
    RESC(alB); __syncthreads();
    SBAR(); qkt(pA0, pA1, K_lds, qr, r32, hi);
    finishSM(pB0, pB1, alB, l_reg, pa0, pa1, pa2, pa3); SBAR();
    if (SDEPTH == 1 || j + 3 < NT) SLOAD(SE, (j + 1 + SDEPTH) * KVBLK); SBAR();
    pv_d0(o, vb0 + (int)SHM_V, pa0, pa1, pa2, pa3); partialSM(pA0, pA1, m_reg, mnA, alA);
    __syncthreads(); SWAIT(); SWRITE(1, SO);
    RESC(alA); __syncthreads();
  }
  SBAR(); qkt(pB0, pB1, (bf16*)((char*)K_lds + SHM_K), qr, r32, hi);
  finishSM(pA0, pA1, alA, l_reg, pa0, pa1, pa2, pa3); SBAR();
  pv_d0(o, vb0, pa0, pa1, pa2, pa3); partialSM(pB0, pB1, m_reg, mnB, alB);
  __syncthreads(); RESC(alB);
  finishSM(pB0, pB1, alB, l_reg, pa0, pa1, pa2, pa3); SBAR();
  pv_d0(o, vb0 + (int)SHM_V, pa0, pa1, pa2, pa3);
  if (hi == 0) li_l[r32] = l_reg; asm volatile("s_waitcnt lgkmcnt(0)" ::: "memory");
  float rli[16];
#pragma unroll
  for (int r = 0; r < 16; ++r) rli[r] = __builtin_amdgcn_rcpf(li_l[crow(r, hi)]);
  float* Ow = Ob + (long)(wid * QBLK) * LDO;
#pragma unroll
  for (int r = 0; r < 16; ++r) { int orow = crow(r, hi);
    for (int d0 = 0; d0 < 4; ++d0) Ow[(long)orow * LDO + d0 * 32 + r32] = o[d0][r] * rli[r]; }
#undef SLOAD
#undef SWRITE
#undef SWAIT
#undef RESC
}

constexpr size_t SHM_V8 = KVBLK * 256 * 2;
constexpr size_t SHM_ATTN8 = 2 * SHM_V8 + 2 * SHM_K + NW * 64 * 4;
__device__ __forceinline__ int v_st8(int k, int c) { const int kk = (k & ~0xC) | ((k & 4) << 1) | ((k & 8) >> 1); return ((kk >> 3) * 8 + (c >> 5)) * 512 + ((kk & 7) * 32 + (c & 31)) * 2; }
constexpr int v_rd_off8(int d0, int ks, int half) { return d0 * 512 + ks * 8192 + half * 4096; }
template <int D0> __device__ __forceinline__ void pv_one8(f32x16& od, int vb, bf16x8 pa0, bf16x8 pa1, bf16x8 pa2, bf16x8 pa3) {
  const s16x4 l0 = tr_read<v_rd_off8(D0, 0, 0)>(vb), h0 = tr_read<v_rd_off8(D0, 0, 1)>(vb), l1 = tr_read<v_rd_off8(D0, 1, 0)>(vb), h1 = tr_read<v_rd_off8(D0, 1, 1)>(vb);
  const s16x4 l2 = tr_read<v_rd_off8(D0, 2, 0)>(vb), h2 = tr_read<v_rd_off8(D0, 2, 1)>(vb), l3 = tr_read<v_rd_off8(D0, 3, 0)>(vb), h3 = tr_read<v_rd_off8(D0, 3, 1)>(vb);
  asm volatile("s_waitcnt lgkmcnt(0)" ::: "memory"); SBAR();
#define PK(L, H) (bf16x8){L[0], L[1], L[2], L[3], H[0], H[1], H[2], H[3]}
  od = __builtin_amdgcn_mfma_f32_32x32x16_bf16(pa0, PK(l0, h0), od, 0, 0, 0);
  od = __builtin_amdgcn_mfma_f32_32x32x16_bf16(pa1, PK(l1, h1), od, 0, 0, 0);
  od = __builtin_amdgcn_mfma_f32_32x32x16_bf16(pa2, PK(l2, h2), od, 0, 0, 0);
  od = __builtin_amdgcn_mfma_f32_32x32x16_bf16(pa3, PK(l3, h3), od, 0, 0, 0);
#undef PK
}
__device__ __forceinline__ void attn_dv256_body(const bf16* __restrict__ Qb, const bf16* __restrict__ Kh, const bf16* __restrict__ Vh,
                                                float* __restrict__ Ob, int seq, char* lds, __attribute__((address_space(3))) unsigned char* ldsl, int tid_in,
                                                int mode, float lam, float post, const float* __restrict__ nw, unsigned short* __restrict__ A2b) {
  int tid_l = tid_in; asm volatile("" : "+v"(tid_l)); const int tid = tid_l, wid = __builtin_amdgcn_readfirstlane(tid >> 6), lane = tid & 63, r32 = lane & 31, hi = lane >> 5;
  bf16* V_lds = (bf16*)lds; bf16* K_lds = (bf16*)(lds + 2 * SHM_V8);
  float* ws = (float*)(lds + 2 * SHM_V8 + 2 * SHM_K) + wid * 64; float* li_l = ws; float* al_l = ws + 32;
  float m_reg = -1e30f, l_reg = 0; f32x16 o[8] = {}; bf16x8 qr[8];
  const bf16* Qw = Qb + (long)(wid * QBLK + r32) * LDQ + hi * 8;
#pragma unroll
  for (int d0 = 0; d0 < 8; ++d0) qr[d0] = *reinterpret_cast<const bf16x8*>(Qw + d0 * 16);
  int koff[2], voff[4];
#pragma unroll
  for (int t = 0; t < 2; ++t) { const int b = (wid * 2 + t) * 1024 + lane * 16; const int row = b >> 8, colB = (b & 255) ^ ((row & 7) << 4); koff[t] = row * LDK + (colB >> 1); }
#pragma unroll
  for (int t = 0; t < 4; ++t) { const int b = (wid * 4 + t) * 1024 + lane * 16; const int sub = b >> 9, w = b & 511, kk = ((sub >> 3) << 3) | (w >> 6), c = ((sub & 7) << 5) | ((w & 63) >> 1);
    const int k = (kk & ~0xC) | ((kk & 4) << 1) | ((kk & 8) >> 1); voff[t] = k * LDK + c; }
  const int vb0 = (int)(uintptr_t)V_lds + v_rd_base(lane);
#define DSTAGE(buf, k0) do { \
    _Pragma("unroll") for (int t = 0; t < 2; ++t) __builtin_amdgcn_global_load_lds((const unsigned*)(Kh + (long)(k0) * LDK + koff[t]), (__attribute__((address_space(3))) unsigned*)(ldsl + 2 * SHM_V8 + (buf) * SHM_K + (wid * 2 + t) * 1024), 16, 0, 0); \
    _Pragma("unroll") for (int t = 0; t < 4; ++t) __builtin_amdgcn_global_load_lds((const unsigned*)(Vh + (long)(k0) * LDK + voff[t]), (__attribute__((address_space(3))) unsigned*)(ldsl + (buf) * SHM_V8 + (wid * 4 + t) * 1024), 16, 0, 0); } while (0)
#define RESC8(a) do { if (__any((a) < 1.f)) { if (hi == 0) al_l[r32] = (a); asm volatile("s_waitcnt lgkmcnt(0)" ::: "memory"); \
    _Pragma("unroll") for (int d = 0; d < 8; ++d) _Pragma("unroll") for (int r = 0; r < 16; ++r) o[d][r] *= al_l[crow(r, hi)]; } } while (0)
  const int NT = seq / KVBLK;
  DSTAGE(0, 0); asm volatile("s_waitcnt vmcnt(0)" ::: "memory"); __syncthreads();
#pragma unroll 1
  for (int j = 0; j < NT; ++j) {
    const int b = j & 1;
    if (j + 1 < NT) DSTAGE(b ^ 1, (j + 1) * KVBLK);
    f32x16 p0, p1; SBAR(); qkt(p0, p1, (const bf16*)((const char*)K_lds + b * SHM_K), qr, r32, hi); SBAR();
    float mn, alpha; partialSM(p0, p1, m_reg, mn, alpha);
    RESC8(alpha);
    bf16x8 pa0, pa1, pa2, pa3; finishSM(p0, p1, alpha, l_reg, pa0, pa1, pa2, pa3); SBAR();
    const int vb = vb0 + b * (int)SHM_V8;
    pv_one8<0>(o[0], vb, pa0, pa1, pa2, pa3); pv_one8<1>(o[1], vb, pa0, pa1, pa2, pa3); pv_one8<2>(o[2], vb, pa0, pa1, pa2, pa3); pv_one8<3>(o[3], vb, pa0, pa1, pa2, pa3);
    pv_one8<4>(o[4], vb, pa0, pa1, pa2, pa3); pv_one8<5>(o[5], vb, pa0, pa1, pa2, pa3); pv_one8<6>(o[6], vb, pa0, pa1, pa2, pa3); pv_one8<7>(o[7], vb, pa0, pa1, pa2, pa3);
    asm volatile("s_waitcnt vmcnt(0)" ::: "memory");
    __syncthreads();
  }
  if (hi == 0) li_l[r32] = l_reg; asm volatile("s_waitcnt lgkmcnt(0)" ::: "memory");
  float rli[16];
#pragma unroll
  for (int r = 0; r < 16; ++r) rli[r] = __builtin_amdgcn_rcpf(li_l[crow(r, hi)]);
  float* Ow = Ob + (long)(wid * QBLK) * LDO;
  if (mode == 0) {
#pragma unroll
    for (int r = 0; r < 16; ++r) { const int orow = crow(r, hi);
#pragma unroll
      for (int d0 = 0; d0 < 8; ++d0) Ow[(long)orow * LDO + d0 * 32 + r32] = o[d0][r] * rli[r]; }
  } else {
    unsigned short* Aw = A2b + (long)(wid * QBLK) * LDO;
    float nwv[8];
#pragma unroll
    for (int d0 = 0; d0 < 8; ++d0) nwv[d0] = nw[d0 * 32 + r32] * post;
#pragma unroll
    for (int r = 0; r < 16; ++r) { const int orow = crow(r, hi); float v[8]; float ss = 0.f;
#pragma unroll
      for (int d0 = 0; d0 < 8; ++d0) { v[d0] = Ow[(long)orow * LDO + d0 * 32 + r32] - lam * (o[d0][r] * rli[r]); ss += v[d0] * v[d0]; }
      ss += __int_as_float(__builtin_amdgcn_ds_swizzle(__float_as_int(ss), (1 << 10) | 0x1f)); ss += __int_as_float(__builtin_amdgcn_ds_swizzle(__float_as_int(ss), (2 << 10) | 0x1f));
      ss += __int_as_float(__builtin_amdgcn_ds_swizzle(__float_as_int(ss), (4 << 10) | 0x1f)); ss += __int_as_float(__builtin_amdgcn_ds_swizzle(__float_as_int(ss), (8 << 10) | 0x1f));
      ss += __int_as_float(__builtin_amdgcn_ds_swizzle(__float_as_int(ss), (16 << 10) | 0x1f));
      const float rr = 1.0f / sqrtf(ss * (1.0f / 256.0f) + 1e-6f);
#pragma unroll
      for (int d0 = 0; d0 < 8; ++d0) { const float x = v[d0] * rr * nwv[d0]; unsigned u = __builtin_bit_cast(unsigned, x); u = (u + 0x7fffu + ((u >> 16) & 1u)) >> 16; Aw[(long)orow * LDO + d0 * 32 + r32] = (unsigned short)u; } }
  }
#undef DSTAGE
#undef RESC8
}
}
#ifndef MK_SPLIT
#define MK_SPLIT 0
#endif
#define LAS __attribute__((address_space(3)))
typedef unsigned short bf16_t;
typedef float f32x4 __attribute__((ext_vector_type(4)));
typedef short bf16x8 __attribute__((ext_vector_type(8)));
typedef unsigned u32x4 __attribute__((ext_vector_type(4)));
typedef unsigned u32x2 __attribute__((ext_vector_type(2)));

#define XB_TMO      128
#define XB_XCNT(j)  (256  + 64 * (j))
#define XB_XSUB(j)  (1280 + 64 * (j))
#define XB_XGEN(j)  (2304 + 64 * (j))
#define XB_TOP      3328
#define XB_TOPGEN   3392
#define XCD_BAR_WORDS 3456
#define XB_SPIN_CAP (1u << 18)

__device__ __forceinline__ unsigned xb_ld(unsigned* p)              { return __hip_atomic_load(p, __ATOMIC_RELAXED, __HIP_MEMORY_SCOPE_AGENT); }
__device__ __forceinline__ unsigned xb_add(unsigned* p, unsigned v) { return __hip_atomic_fetch_add(p, v, __ATOMIC_RELAXED, __HIP_MEMORY_SCOPE_AGENT); }
__device__ __forceinline__ unsigned xb_xcc_id() { return (unsigned)__builtin_amdgcn_s_getreg((3 << 11) | 20) & 0xFu; }
#define XB_SPIN(cond, bar) do { unsigned _sp = 0; while (cond) { __builtin_amdgcn_s_sleep(1); \
    if ((++_sp & 255u) == 0u) { if (xb_ld(&(bar)[XB_TMO])) break; if (_sp > XB_SPIN_CAP) { atomicAdd(&(bar)[XB_TMO], 1u); break; } } } } while (0)

struct XcdBarrier {
    unsigned* bar; unsigned x;
    volatile LAS unsigned* st;
};

__device__ __forceinline__ XcdBarrier xcd_barrier_post(unsigned* bar, volatile LAS unsigned* st) {
    XcdBarrier b; b.bar = bar; b.x = xb_xcc_id(); b.st = st;
    if (threadIdx.x == 0) (void)xb_add(&bar[XB_XCNT(b.x)], 1u);
    return b;
}
__device__ __forceinline__ void xcd_barrier_complete(unsigned* bar, unsigned x, unsigned& nloc, unsigned& nx) {
    const unsigned G = gridDim.x * gridDim.y * gridDim.z;
    unsigned sum, cnt, mine, sp = 0u;
    for (;;) {
        sum = 0u; cnt = 0u; mine = 0u;
#pragma unroll
        for (unsigned j = 0; j < 16; ++j) { const unsigned c = xb_ld(&bar[XB_XCNT(j)]); sum += c; cnt += (c > 0u) ? 1u : 0u; mine = (j == x) ? c : mine; }
        if (sum == G) break;
        __builtin_amdgcn_s_sleep(1);
        if ((++sp & 255u) == 0u) { if (xb_ld(&bar[XB_TMO])) break; if (sp > XB_SPIN_CAP) { atomicAdd(&bar[XB_TMO], 1u); break; } }
    }
    nloc = mine > 0u ? mine : 1u; nx = cnt > 0u ? cnt : 1u;
}

__device__ __forceinline__ void xcd_barrier(const XcdBarrier& b) {
    asm volatile("s_waitcnt vmcnt(0)" ::: "memory");
    __syncthreads();
    if (threadIdx.x == 0) {
        unsigned* bar = b.bar;
        __builtin_amdgcn_s_waitcnt(0);
        unsigned nloc = b.st[0], nx = b.st[1];
        if (nloc == 0u) { xcd_barrier_complete(bar, b.x, nloc, nx); b.st[0] = nloc; b.st[1] = nx; }
        const unsigned old = xb_add(&bar[XB_XSUB(b.x)], 1u);
        const unsigned gen = old / nloc;
        if (old + 1u == (gen + 1u) * nloc) {
            __builtin_amdgcn_fence(__ATOMIC_RELEASE, "agent");
            asm volatile("s_waitcnt vmcnt(0)" ::: "memory");
            const unsigned og = xb_add(&bar[XB_TOP], 1u);
            const unsigned tg = og / nx;
            if (og + 1u == (tg + 1u) * nx) xb_add(&bar[XB_TOPGEN], 1u);
            else XB_SPIN(xb_ld(&bar[XB_TOPGEN]) == tg, bar);
            __builtin_amdgcn_fence(__ATOMIC_ACQUIRE, "agent");
            xb_add(&bar[XB_XGEN(b.x)], 1u);
            asm volatile("s_waitcnt vmcnt(0)" ::: "memory");
        } else {
            XB_SPIN(xb_ld(&bar[XB_XGEN(b.x)]) == gen, bar);
            __builtin_amdgcn_fence(__ATOMIC_ACQUIRE, "agent");
            asm volatile("s_waitcnt vmcnt(0)" ::: "memory");
        }
    }
    __syncthreads();
}

constexpr int DM = 2048, SEQ = 8192, CTXL = 256, MROWS = SEQ + CTXL, DFF = 5632, NMOD = 9 * DM;
constexpr int IN0 = 4128, IN0P = 4352, QKVN = 6144;
constexpr int C_Q = 0, C_K = 512, C_V = 1024, C_R = 2048, C_GF = 3072, C_U = 3104;
constexpr int NCHUNK = 132, NITEM = 8 * NCHUNK;
constexpr float EPS = 1e-6f;
constexpr int ADA_KC = 16;

constexpr size_t MiB = 1u << 20;
constexpr size_t WS_MOD = 0, WS_ADAP = 1 * MiB, WS_ROPEC = 6 * MiB, WS_ROPES = 8 * MiB, WS_POOLW = 10 * MiB, WS_GLAD = 11 * MiB;
constexpr size_t WS_W13 = 12 * MiB, WS_W2 = 188 * MiB, WS_WIN = 276 * MiB, WS_WOUT0 = 293 * MiB, WS_WQKV = 301 * MiB, WS_WOUT1 = 325 * MiB;
constexpr size_t WS_H = 333 * MiB, WS_Z = 399 * MiB, WS_U = 432 * MiB, WS_PROJ = 523 * MiB, WS_A2 = 622 * MiB, WS_POOLED = 655 * MiB;
constexpr size_t WS_L = 672 * MiB, WS_STB = 804 * MiB, WS_OF = 870 * MiB, WS_OB = 903 * MiB, WS_ATT0 = 672 * MiB, WS_ATT1 = 736 * MiB, WS_CTL = 936 * MiB, WS_PART = 937 * MiB, WS_BCUM = 960 * MiB, WS_END = 994 * MiB;
constexpr size_t CTL_ZERO_BYTES = 16384;
constexpr size_t W13_BYTES = (size_t)2 * DFF * DM * 2, W2_BYTES = (size_t)DM * DFF * 2;
static_assert(WS_W13 + 4 * W13_BYTES <= WS_W2 && WS_W2 + 4 * W2_BYTES <= WS_WIN && WS_WIN + (size_t)IN0P * DM * 2 <= WS_WOUT0 && WS_WQKV + (size_t)QKVN * DM * 2 <= WS_WOUT1, "ws map (weights)");
static_assert(WS_H + (size_t)MROWS * DM * 4 <= WS_Z && WS_Z + (size_t)MROWS * DM * 2 <= WS_U && WS_U + (size_t)MROWS * DFF * 2 <= WS_PROJ && WS_PROJ + (size_t)MROWS * QKVN * 2 <= WS_A2, "ws map (act)");
static_assert(WS_A2 + (size_t)MROWS * DM * 2 <= WS_POOLED && WS_POOLED + (size_t)4 * MROWS * 256 * 2 <= WS_L && WS_L + (size_t)NITEM * 32768 * 4 <= WS_STB && WS_STB + (size_t)NITEM * 32768 * 2 <= WS_OF, "ws map (gla)");
static_assert(WS_OF + (size_t)MROWS * 1024 * 4 <= WS_OB && WS_OB + (size_t)MROWS * 1024 * 4 <= WS_CTL && XCD_BAR_WORDS * 4 <= CTL_ZERO_BYTES && WS_ATT1 + (size_t)SEQ * DM * 4 <= WS_STB, "ws map (out)");

constexpr int LDS_BYTES = 147456;

__device__ __forceinline__ unsigned f2bf(float f) { unsigned u = __builtin_bit_cast(unsigned, f); return (u + 0x7fffu + ((u >> 16) & 1u)) >> 16; }
__device__ __forceinline__ unsigned pk2(float lo, float hi) { return f2bf(lo) | (f2bf(hi) << 16); }
__device__ __forceinline__ float bf2f(unsigned v) { return __uint_as_float(v << 16); }
__device__ __forceinline__ float bfel(const u32x4& r, int j) { return __uint_as_float(((r[j >> 1] >> ((j & 1) * 16)) & 0xffffu) << 16); }
__device__ __forceinline__ unsigned bfraw(const u32x4& r, int j) { return (r[j >> 1] >> ((j & 1) * 16)) & 0xffffu; }
template <int X> __device__ __forceinline__ float xor_add(float v) { return v + __int_as_float(__builtin_amdgcn_ds_swizzle(__float_as_int(v), (X << 10) | 0x1f)); }
__device__ __forceinline__ float wave_sum(float v) {
    v = xor_add<1>(v); v = xor_add<2>(v); v = xor_add<4>(v); v = xor_add<8>(v); v = xor_add<16>(v);
    auto rr = __builtin_amdgcn_permlane32_swap(__float_as_uint(v), __float_as_uint(v), false, false);
    return __uint_as_float(rr[0]) + __uint_as_float(rr[1]);
}
__device__ __forceinline__ float silu_x(float x) { return x / (1.0f + __expf(-x)); }
__device__ __forceinline__ float log_sigmoid_f(float z) { return fminf(z, 0.f) - __logf(1.0f + __expf(-fabsf(z))); }

template <int MODE> __device__ __forceinline__ int rowmap(int n, int aux) {
    if (MODE == 0) return n + aux;
    if (MODE == 1) return (n >> 7) * 256 + aux * 128 + (n & 127);
    if (n >= 4096) return n;
    const int d = n & 127; return (n & ~127) + 8 * ((d & 63) >> 2) + 4 * (d >> 6) + (d & 3);
}
template <int MODE> __device__ __forceinline__ void transpose_item(const float* __restrict__ W, int K, int N, bf16_t* __restrict__ WT, int aux, LAS float* scr, int item, int lane) {
    const int nblk = N / 32, kb = item / nblk, nb = item % nblk, k0 = 64 * kb, n0 = 32 * nb;
#pragma unroll 8
    for (int i = 0; i < 32; ++i) { const int kk = 2 * i + (lane >> 5); scr[kk * 33 + (lane & 31)] = W[(size_t)(k0 + kk) * N + n0 + (lane & 31)]; }
    asm volatile("s_waitcnt lgkmcnt(0)" ::: "memory");
    const int c = lane & 7;
#pragma unroll
    for (int j = 0; j < 4; ++j) { const int n = (lane >> 3) + 8 * j; const LAS float* s = scr + (8 * c) * 33 + n;
        u32x4 o; o.x = pk2(s[0 * 33], s[1 * 33]); o.y = pk2(s[2 * 33], s[3 * 33]); o.z = pk2(s[4 * 33], s[5 * 33]); o.w = pk2(s[6 * 33], s[7 * 33]);
        *(u32x4*)(WT + (size_t)rowmap<MODE>(n0 + n, aux) * K + k0 + 8 * c) = o; }
    asm volatile("s_waitcnt lgkmcnt(0)" ::: "memory");
}
struct RowBuf { f32x4 v[8]; u32x2 d[8]; };
__device__ __forceinline__ void row_load(RowBuf& b, const float* __restrict__ src, const bf16_t* __restrict__ dl, int lane) {
    const f32x4* hr = (const f32x4*)src + lane;
#pragma unroll
    for (int j = 0; j < 8; ++j) b.v[j] = hr[64 * j];
    if (dl) { const u32x2* dr = (const u32x2*)dl + lane;
#pragma unroll
        for (int j = 0; j < 8; ++j) b.d[j] = dr[64 * j]; }
}
__device__ __forceinline__ float row_finish(RowBuf& b, bool has_d) {
    float ss = 0.f;
#pragma unroll
    for (int j = 0; j < 8; ++j) {
        if (has_d) { b.v[j].x += bf2f(b.d[j].x & 0xffffu); b.v[j].y += bf2f(b.d[j].x >> 16); b.v[j].z += bf2f(b.d[j].y & 0xffffu); b.v[j].w += bf2f(b.d[j].y >> 16); }
        ss += (b.v[j].x * b.v[j].x + b.v[j].y * b.v[j].y) + (b.v[j].z * b.v[j].z + b.v[j].w * b.v[j].w); }
    return 1.0f / sqrtf(wave_sum(ss) * (1.0f / DM) + EPS);
}
__device__ __forceinline__ void norm_mod_phase(const float* __restrict__ srcL, const float* __restrict__ srcC, const bf16_t* __restrict__ DL, float* __restrict__ H, bool wbL, bool wbC,
                                               const float* __restrict__ PART, int nparts, bf16_t* __restrict__ Z, const float* mod_lat, const float* mod_ctx, int slot, int nrows_in, int gw, int NGW, int lane,
                                               LAS unsigned char* lds, int bx, int G, int wave) {
    if (nrows_in > SEQ) {
        LAS float* red = (LAS float*)lds;
        for (int cr = bx; cr < CTXL; cr += G) {
            const int col = wave * 256 + lane * 4;
            f32x4 v = *(const f32x4*)(srcC + (size_t)cr * DM + col);
            f32x4 ps[11];
#pragma unroll
            for (int ks = 0; ks < 11; ++ks) ps[ks] = (ks < nparts) ? *(const f32x4*)(PART + ((size_t)ks * 256 + cr) * DM + col) : (f32x4){0.f, 0.f, 0.f, 0.f};
#pragma unroll
            for (int ks = 0; ks < 11; ++ks) v = v + ps[ks];
            const float ssw = wave_sum((v.x * v.x + v.y * v.y) + (v.z * v.z + v.w * v.w));
            if (lane == 0) red[wave] = ssw;
            __syncthreads();
            const float tot = ((red[0] + red[1]) + (red[2] + red[3])) + ((red[4] + red[5]) + (red[6] + red[7]));
            const float rr = 1.0f / sqrtf(tot * (1.0f / DM) + EPS);
            const float* sh = mod_ctx + (size_t)slot * DM; const float* sc = sh + DM;
            if (wbC || nparts > 0) *(f32x4*)(H + (size_t)(SEQ + cr) * DM + col) = v;
            const f32x4 o = v * rr * (*(const f32x4*)(sc + col) + 1.0f) + *(const f32x4*)(sh + col);
            *(unsigned long long*)(Z + (size_t)(SEQ + cr) * DM + col) = (unsigned long long)pk2(o.x, o.y) | ((unsigned long long)pk2(o.z, o.w) << 32);
            __syncthreads();
        }
    }
    const int nrows = nrows_in < SEQ ? nrows_in : SEQ;
    RowBuf A, B;
    f32x4 sc1[8], shv[8]; int kind = -1;
#define NM_SRC(r) ((r) < SEQ ? srcL + (size_t)(r) * DM : srcC + (size_t)((r) - SEQ) * DM)
#define NM_DL(r) (((r) < SEQ && DL) ? DL + (size_t)(r) * DM : (const bf16_t*)nullptr)
#define NM_DO(buf, r) do { const bool ctxr = (r) >= SEQ; \
        if (ctxr) { for (int ks = 0; ks < nparts; ++ks) { const f32x4* pr = (const f32x4*)(PART + ((size_t)ks * 256 + ((r) - SEQ)) * DM) + lane; _Pragma("unroll") for (int j = 0; j < 8; ++j) buf.v[j] = buf.v[j] + pr[64 * j]; } } \
        const float rr = row_finish(buf, !ctxr && DL != nullptr); \
        if (kind != (int)ctxr) { kind = (int)ctxr; const float* sh = (ctxr ? mod_ctx : mod_lat) + (size_t)slot * DM; const float* sc = sh + DM; \
            _Pragma("unroll") for (int j = 0; j < 8; ++j) { const int col = 4 * lane + 256 * j; sc1[j] = *(const f32x4*)(sc + col) + 1.0f; shv[j] = *(const f32x4*)(sh + col); } } \
        if (ctxr ? (wbC || nparts > 0) : wbL) { f32x4* ho = (f32x4*)(H + (size_t)(r) * DM) + lane; _Pragma("unroll") for (int j = 0; j < 8; ++j) ho[64 * j] = buf.v[j]; } \
        unsigned long long* zo = (unsigned long long*)(Z + (size_t)(r) * DM) + lane; \
        _Pragma("unroll") for (int j = 0; j < 8; ++j) { \
            const f32x4 o = buf.v[j] * rr * sc1[j] + shv[j]; zo[64 * j] = (unsigned long long)pk2(o.x, o.y) | ((unsigned long long)pk2(o.z, o.w) << 32); } } while (0)
    int row = nrows - 1 - gw;
    if (row >= 0) row_load(A, NM_SRC(row), NM_DL(row), lane);
    while (row >= 0) {
        const int r1 = row - NGW; if (r1 >= 0) row_load(B, NM_SRC(r1), NM_DL(r1), lane);
        NM_DO(A, row);
        if (r1 < 0) break;
        const int r2 = r1 - NGW; if (r2 >= 0) row_load(A, NM_SRC(r2), NM_DL(r2), lane);
        NM_DO(B, r1);
        row = r2;
    }
#undef NM_SRC
#undef NM_DL
#undef NM_DO
}
__device__ __forceinline__ void final_norm_phase(const float* __restrict__ H, const bf16_t* __restrict__ DL, float* __restrict__ out, const float* __restrict__ fnw, int gw, int NGW, int lane) {
    RowBuf A, B;
#define FN_DO(buf, r) do { const float rr = row_finish(buf, DL != nullptr); f32x4* o = (f32x4*)(out + (size_t)(r) * DM) + lane; \
        _Pragma("unroll") for (int j = 0; j < 8; ++j) { const f32x4 w4 = *(const f32x4*)(fnw + 4 * lane + 256 * j); o[64 * j] = buf.v[j] * rr * w4; } } while (0)
    int row = gw;
    if (row < SEQ) row_load(A, H + (size_t)row * DM, DL ? DL + (size_t)row * DM : DL, lane);
    while (row < SEQ) {
        const int r1 = row + NGW; if (r1 < SEQ) row_load(B, H + (size_t)r1 * DM, DL ? DL + (size_t)r1 * DM : DL, lane);
        FN_DO(A, row);
        if (r1 >= SEQ) break;
        const int r2 = r1 + NGW; if (r2 < SEQ) row_load(A, H + (size_t)r2 * DM, DL ? DL + (size_t)r2 * DM : DL, lane);
        FN_DO(B, r1);
        row = r2;
    }
#undef FN_DO
}
__device__ __forceinline__ void gla_readout_phase(const float* __restrict__ OF, const float* __restrict__ OB, const bf16_t* __restrict__ PROJ, const float* __restrict__ nw, bf16_t* __restrict__ A2, int gw, int NGW, int lane) {
    const int c0 = (lane & 15) * 16;
    float nwv[16];
#pragma unroll
    for (int j = 0; j < 16; ++j) nwv[j] = nw[c0 + j];
    struct RB { f32x4 a[4], b[4]; u32x4 r0, r1; };
#define RD_LOAD(B_, r_) do { const f32x4* a_ = (const f32x4*)(OF + (size_t)(r_) * 1024 + lane * 16); const f32x4* b_ = (const f32x4*)(OB + (size_t)(r_) * 1024 + lane * 16); \
        _Pragma("unroll") for (int j = 0; j < 4; ++j) { B_.a[j] = a_[j]; B_.b[j] = b_[j]; } \
        const u32x4* rp_ = (const u32x4*)(PROJ + (size_t)(r_) * IN0P + C_R + lane * 16); B_.r0 = rp_[0]; B_.r1 = rp_[1]; } while (0)
#define RD_DO(B_, r_) do { f32x4 v[4]; float ss = 0.f; \
        _Pragma("unroll") for (int j = 0; j < 4; ++j) { v[j] = B_.a[j] + B_.b[j]; ss += (v[j].x * v[j].x + v[j].y * v[j].y) + (v[j].z * v[j].z + v[j].w * v[j].w); } \
        ss = xor_add<1>(ss); ss = xor_add<2>(ss); ss = xor_add<4>(ss); ss = xor_add<8>(ss); \
        const float r = 1.0f / sqrtf(ss * (1.0f / 256.0f) + EPS); float o[16]; \
        _Pragma("unroll") for (int j = 0; j < 16; ++j) { const float rv = (j < 8) ? bfel(B_.r0, j) : bfel(B_.r1, j - 8); o[j] = v[j >> 2][j & 3] * r * nwv[j] * (rv * __builtin_amdgcn_rcpf(1.0f + __expf(-rv))); } \
        u32x4 w0, w1; w0.x = pk2(o[0], o[1]); w0.y = pk2(o[2], o[3]); w0.z = pk2(o[4], o[5]); w0.w = pk2(o[6], o[7]); w1.x = pk2(o[8], o[9]); w1.y = pk2(o[10], o[11]); w1.z = pk2(o[12], o[13]); w1.w = pk2(o[14], o[15]); \
        u32x4* op = (u32x4*)(A2 + (size_t)(r_) * DM + lane * 16); op[0] = w0; op[1] = w1; } while (0)
    {
        const int wv = gw & 7, bxr = gw >> 3, Gr = NGW >> 3;
        if (wv < 4) for (int cr = bxr; cr < CTXL; cr += Gr) { const int row = SEQ + cr, col = wv * 256 + lane * 4;
            const f32x4 v = *(const f32x4*)(OF + (size_t)row * 1024 + col) + *(const f32x4*)(OB + (size_t)row * 1024 + col);
            const unsigned long long rw = *(const unsigned long long*)(PROJ + (size_t)row * IN0P + C_R + col);
            const float ss = wave_sum((v.x * v.x + v.y * v.y) + (v.z * v.z + v.w * v.w));
            const float r = 1.0f / sqrtf(ss * (1.0f / 256.0f) + EPS);
            const f32x4 n4 = *(const f32x4*)(nw + lane * 4);
            const float r0 = bf2f((unsigned)(rw & 0xffffu)), r1 = bf2f((unsigned)((rw >> 16) & 0xffffu)), r2 = bf2f((unsigned)((rw >> 32) & 0xffffu)), r3 = bf2f((unsigned)(rw >> 48));
            const float o0 = v.x * r * n4.x * silu_x(r0), o1 = v.y * r * n4.y * silu_x(r1), o2 = v.z * r * n4.z * silu_x(r2), o3 = v.w * r * n4.w * silu_x(r3);
            *(unsigned long long*)(A2 + (size_t)row * DM + col) = (unsigned long long)pk2(o0, o1) | ((unsigned long long)pk2(o2, o3) << 32); }
    }
    RB A, B;
    int row = gw;
    if (row < SEQ) RD_LOAD(A, row);
    while (row < SEQ) {
        const int r1 = row + NGW; if (r1 < SEQ) RD_LOAD(B, r1);
        RD_DO(A, row);
        if (r1 >= SEQ) break;
        const int r2 = r1 + NGW; if (r2 < SEQ) RD_LOAD(A, r2);
        RD_DO(B, r1);
        row = r2;
    }
#undef RD_LOAD
#undef RD_DO
}
__device__ __forceinline__ void diff_combine_phase(const float* __restrict__ A0, const float* __restrict__ A1, const float* __restrict__ lp, const float* __restrict__ nw, bf16_t* __restrict__ A2, int gw, int NGW, int lane) {
    const float lam_init = 0.8f - 0.6f * 0.74081822068171786607f;
    const float s01 = wave_sum(lp[lane] * lp[128 + lane] + lp[64 + lane] * lp[192 + lane]);
    const float s23 = wave_sum(lp[256 + lane] * lp[384 + lane] + lp[320 + lane] * lp[448 + lane]);
    const float lam = expf(s01) - expf(s23) + lam_init;
    const float post = 1.0f - lam_init;
    for (int row = gw; row < SEQ; row += NGW) {
        const f32x4* a = (const f32x4*)(A0 + (size_t)row * DM + lane * 32); const f32x4* b = (const f32x4*)(A1 + (size_t)row * DM + lane * 32);
        f32x4 v[8]; float ss = 0.f;
#pragma unroll
        for (int j = 0; j < 8; ++j) { v[j] = a[j] - b[j] * lam; ss += (v[j].x * v[j].x + v[j].y * v[j].y) + (v[j].z * v[j].z + v[j].w * v[j].w); }
        ss = xor_add<1>(ss); ss = xor_add<2>(ss); ss = xor_add<4>(ss);
        const float r = post / sqrtf(ss * (1.0f / 256.0f) + EPS);
        const int c0 = (lane & 7) * 32;
        u32x4* op = (u32x4*)(A2 + (size_t)row * DM + lane * 32);
#pragma unroll
        for (int j = 0; j < 4; ++j) { const f32x4 w0 = *(const f32x4*)(nw + c0 + 8 * j), w1 = *(const f32x4*)(nw + c0 + 8 * j + 4); const f32x4 x0 = v[2 * j] * r * w0, x1 = v[2 * j + 1] * r * w1;
            u32x4 w; w.x = pk2(x0.x, x0.y); w.y = pk2(x0.z, x0.w); w.z = pk2(x1.x, x1.y); w.w = pk2(x1.z, x1.w); op[j] = w; }
    }
}
__device__ __forceinline__ void pool_phase(const bf16_t* __restrict__ PROJ, bf16_t* __restrict__ POOLED, int gtid, int NT) {
    for (int idx = gtid; idx < MROWS * 128; idx += NT) {
        const int row = idx >> 7, c8 = idx & 127, g = c8 >> 5, hw = 1 << g;
        const int L0 = row < SEQ ? 0 : SEQ, L1 = row < SEQ ? SEQ : MROWS;
        const int lo = max(row - hw, L0), hi = min(row + hw, L1);
        float s[8];
#pragma unroll
        for (int j = 0; j < 8; ++j) s[j] = 0.f;
        u32x4 xs[16];
#pragma unroll
        for (int i = 0; i < 16; ++i) { const int r = lo + i; xs[i] = (r < hi) ? *(const u32x4*)(PROJ + (size_t)r * IN0P + C_U + c8 * 8) : (u32x4){0u, 0u, 0u, 0u}; }
#pragma unroll
        for (int i = 0; i < 16; ++i) {
#pragma unroll
            for (int j = 0; j < 8; ++j) s[j] += bfel(xs[i], j); }
        const u32x4 x = *(const u32x4*)(PROJ + (size_t)row * IN0P + C_U + c8 * 8);
        const float inv = 1.0f / (float)(hi - lo);
        float o[8];
#pragma unroll
        for (int j = 0; j < 8; ++j) o[j] = s[j] * inv - bfel(x, j);
        u32x4 w; w.x = pk2(o[0], o[1]); w.y = pk2(o[2], o[3]); w.z = pk2(o[4], o[5]); w.w = pk2(o[6], o[7]);
        *(u32x4*)(POOLED + ((size_t)g * MROWS + row) * 256 + (c8 & 31) * 8) = w;
    }
}

constexpr int GL_GZ = 0, GL_W2 = 4096, GL_BI = 12288, GL_G = 13312, GL_GS = 129;
__device__ __forceinline__ int gla_base(int dir, int c) { return dir == 0 ? (c < 4 ? SEQ + 64 * c : 64 * (c - 4)) : (c < 4 ? SEQ + 192 - 64 * c : SEQ - 64 - 64 * (c - 4)); }
__device__ __forceinline__ void gla_gates(LAS unsigned char* lds, const bf16_t* __restrict__ PROJ, int base, int dir, int head, const float* __restrict__ gw2, const float* __restrict__ gb, int tid) {
    LAS float* GZ = (LAS float*)(lds + GL_GZ); LAS float* W2 = (LAS float*)(lds + GL_W2); LAS float* BI = (LAS float*)(lds + GL_BI); LAS float* Gm = (LAS float*)(lds + GL_G);
    for (int i = tid; i < 1024; i += 512) { const int s = i >> 4, r = i & 15; GZ[i] = bf2f(PROJ[(size_t)(base + s) * IN0P + C_GF + dir * 16 + r]); }
    for (int i = tid; i < 2048; i += 512) { const int r = i >> 7, k = i & 127; W2[i] = gw2[(dir * 16 + r) * 512 + head * 128 + k]; }
    if (tid < 128) BI[tid] = gb[dir * 512 + head * 128 + tid];
    __syncthreads();
    for (int i = tid; i < 8192; i += 512) { const int s = i >> 7, k = i & 127; float zz = BI[k];
#pragma unroll
        for (int r = 0; r < 16; ++r) zz += GZ[s * 16 + r] * W2[r * 128 + k];
        Gm[s * GL_GS + k] = log_sigmoid_f(zz) * 0.0625f; }
    __syncthreads();
    {
        LAS float* TOT = GZ; const int k = tid & 127, seg = tid >> 7;
        float v[16];
#pragma unroll
        for (int j = 0; j < 16; ++j) v[j] = Gm[(seg * 16 + j) * GL_GS + k];
        if (dir == 0) {
#pragma unroll
            for (int j = 1; j < 16; ++j) v[j] += v[j - 1];
        } else {
#pragma unroll
            for (int j = 14; j >= 0; --j) v[j] += v[j + 1];
        }
        TOT[seg * 128 + k] = dir == 0 ? v[15] : v[0];
        __syncthreads();
        float off = 0.f;
#pragma unroll
        for (int s2 = 0; s2 < 4; ++s2) { const float t = TOT[s2 * 128 + k]; off += (dir == 0 ? (s2 < seg) : (s2 > seg)) ? t : 0.f; }
#pragma unroll
        for (int j = 0; j < 16; ++j) Gm[(seg * 16 + j) * GL_GS + k] = v[j] + off;
    }
    __syncthreads();
}
__device__ __forceinline__ void gla_phase_a(LAS unsigned char* lds, const bf16_t* __restrict__ PROJ, const float* __restrict__ gw2, const float* __restrict__ gb, float* __restrict__ L, float* __restrict__ Dd, float* __restrict__ BC, int bx, int G, int tid) {
    const int lane = tid & 63, wave = tid >> 6, fr = lane & 15, fq = lane >> 4;
    LAS float* Gm = (LAS float*)(lds + GL_G); LAS bf16_t* KT = (LAS bf16_t*)(lds + 46336); LAS bf16_t* VT = (LAS bf16_t*)(lds + 64768);
    for (int item = bx; item < NITEM; item += G) {
        const int stream = item / NCHUNK, chunk = item % NCHUNK, dir = stream >> 2, head = stream & 3, base = gla_base(dir, chunk), slast = dir == 0 ? 63 : 0;
        u32x4 rk[2], rv[4];
#pragma unroll
        for (int t = 0; t < 2; ++t) { const int i = tid + t * 512, s = i & 63, c8 = (i >> 6) * 8; rk[t] = *(const u32x4*)(PROJ + (size_t)(base + s) * IN0P + C_K + head * 128 + c8); }
#pragma unroll
        for (int t = 0; t < 4; ++t) { const int i = tid + t * 512, s = i & 63, c8 = (i >> 6) * 8; rv[t] = *(const u32x4*)(PROJ + (size_t)(base + s) * IN0P + C_V + head * 256 + c8); }
        gla_gates(lds, PROJ, base, dir, head, gw2, gb, tid);
#pragma unroll
        for (int t = 0; t < 4; ++t) { const int i = tid + t * 512, s = i >> 5, k = (i & 31) * 4;
            *(f32x4*)(BC + (size_t)item * 8192 + s * 128 + k) = (f32x4){Gm[s * GL_GS + k], Gm[s * GL_GS + k + 1], Gm[s * GL_GS + k + 2], Gm[s * GL_GS + k + 3]}; }
#pragma unroll
        for (int t = 0; t < 2; ++t) { const int i = tid + t * 512, s = i & 63, c8 = (i >> 6) * 8;
#pragma unroll
            for (int j = 0; j < 8; ++j) { const int k = c8 + j; const float e = __expf(Gm[slast * GL_GS + k] - Gm[s * GL_GS + k]); KT[k * 72 + s] = (bf16_t)f2bf(bfel(rk[t], j) * e); } }
#pragma unroll
        for (int t = 0; t < 4; ++t) { const int i = tid + t * 512, s = i & 63, c8 = (i >> 6) * 8;
#pragma unroll
            for (int j = 0; j < 8; ++j) VT[(c8 + j) * 72 + s] = (bf16_t)bfraw(rv[t], j); }
        __syncthreads();
        f32x4 acc[2][8];
#pragma unroll
        for (int mi = 0; mi < 2; ++mi)
#pragma unroll
            for (int ni = 0; ni < 8; ++ni) acc[mi][ni] = (f32x4){0.f, 0.f, 0.f, 0.f};
#pragma unroll
        for (int ks = 0; ks < 2; ++ks) {
            bf16x8 a[2], b[8];
#pragma unroll
            for (int mi = 0; mi < 2; ++mi) a[mi] = *(const LAS bf16x8*)(VT + (wave * 32 + mi * 16 + fr) * 72 + ks * 32 + fq * 8);
#pragma unroll
            for (int ni = 0; ni < 8; ++ni) b[ni] = *(const LAS bf16x8*)(KT + (ni * 16 + fr) * 72 + ks * 32 + fq * 8);
#pragma unroll
            for (int mi = 0; mi < 2; ++mi)
#pragma unroll
                for (int ni = 0; ni < 8; ++ni) acc[mi][ni] = __builtin_amdgcn_mfma_f32_16x16x32_bf16(b[ni], a[mi], acc[mi][ni], 0, 0, 0);
        }
        float* Lp = L + (size_t)item * 32768;
#pragma unroll
        for (int mi = 0; mi < 2; ++mi)
#pragma unroll
            for (int ni = 0; ni < 8; ++ni)
                *(f32x4*)(Lp + (wave * 32 + mi * 16 + fr) * 128 + ni * 16 + fq * 4) = acc[mi][ni];
        if (tid < 128) Dd[item * 128 + tid] = __expf(Gm[slast * GL_GS + tid]);
        __syncthreads();
    }
}
__device__ __forceinline__ void gla_phase_b(const float* __restrict__ L, const float* __restrict__ Dd, bf16_t* __restrict__ STB, int gtid, int NT) {
    for (int g = gtid; g < 8 * 8192; g += NT) {
        const int stream = g >> 13, e4 = g & 8191;
        const f32x4* Lp = (const f32x4*)(L + (size_t)stream * NCHUNK * 32768) + e4;
        u32x2* Sp = (u32x2*)(STB + (size_t)stream * NCHUNK * 32768) + e4;
        const f32x4* Dp = (const f32x4*)(Dd + stream * NCHUNK * 128) + (e4 & 31);
        f32x4 s = (f32x4){0.f, 0.f, 0.f, 0.f};
#pragma unroll 1
        for (int c = 0; c < NCHUNK; c += 12) {
            f32x4 l[12], d[12];
#pragma unroll
            for (int j = 0; j < 12; ++j) { l[j] = Lp[(size_t)(c + j) * 8192]; d[j] = Dp[(c + j) * 32]; }
#pragma unroll
            for (int j = 0; j < 12; ++j) { u32x2 w; w.x = pk2(s.x, s.y); w.y = pk2(s.z, s.w); Sp[(size_t)(c + j) * 8192] = w; s = d[j] * s + l[j]; }
        }
    }
}
__device__ __forceinline__ void gla_phase_c(LAS unsigned char* lds, const bf16_t* __restrict__ PROJ, const float* __restrict__ BC, const bf16_t* __restrict__ STB, float* __restrict__ OF, float* __restrict__ OB, int bx, int G, int tid) {
    const int lane = tid & 63, wave = tid >> 6, fr = lane & 15, fq = lane >> 4;
    LAS float* Gm = (LAS float*)(lds + GL_G); LAS bf16_t* P = (LAS bf16_t*)(lds + GL_G);
    LAS bf16_t* QT = (LAS bf16_t*)(lds + 46336); LAS bf16_t* KT2 = (LAS bf16_t*)(lds + 63744); LAS bf16_t* VT = (LAS bf16_t*)(lds + 81152); LAS bf16_t* SB = (LAS bf16_t*)(lds + 99584);
    for (int it2 = bx; it2 < 2 * NITEM; it2 += G) {
        const int item = it2 >> 1, vh = it2 & 1;
        const int stream = item / NCHUNK, chunk = item % NCHUNK, dir = stream >> 2, head = stream & 3, base = gla_base(dir, chunk);
        u32x4 rq[2], rk[2], rv[2], rs[4];
#pragma unroll
        for (int t = 0; t < 2; ++t) { const int i = tid + t * 512, s = i >> 4, c8 = (i & 15) * 8;
            rq[t] = *(const u32x4*)(PROJ + (size_t)(base + s) * IN0P + C_Q + head * 128 + c8); rk[t] = *(const u32x4*)(PROJ + (size_t)(base + s) * IN0P + C_K + head * 128 + c8); }
#pragma unroll
        for (int t = 0; t < 2; ++t) { const int i = tid + t * 512, s = i & 63, c8 = (i >> 6) * 8; rv[t] = *(const u32x4*)(PROJ + (size_t)(base + s) * IN0P + C_V + head * 256 + vh * 128 + c8); }
#pragma unroll
        for (int t = 0; t < 4; ++t) { const int i = tid + t * 512, v = i >> 4, c8 = (i & 15) * 8; rs[t] = *(const u32x4*)(STB + (size_t)item * 32768 + (size_t)(vh * 128 + v) * 128 + c8); }
        f32x4 gq[2][2];
#pragma unroll
        for (int t = 0; t < 2; ++t) { const int i = tid + t * 512, s = i >> 4, c8 = (i & 15) * 8; gq[t][0] = *(const f32x4*)(BC + (size_t)item * 8192 + s * 128 + c8); gq[t][1] = *(const f32x4*)(BC + (size_t)item * 8192 + s * 128 + c8 + 4); }
#pragma unroll
        for (int t = 0; t < 2; ++t) { const int i = tid + t * 512, s = i >> 4, c8 = (i & 15) * 8;
            float qo[8], ko[8];
#pragma unroll
            for (int j = 0; j < 8; ++j) { const float b = gq[t][j >> 2][j & 3]; qo[j] = bfel(rq[t], j) * 0.088388347648318440f * __expf(b); ko[j] = bfel(rk[t], j) * __expf(-b); }
            u32x4 wq, wk; wq.x = pk2(qo[0], qo[1]); wq.y = pk2(qo[2], qo[3]); wq.z = pk2(qo[4], qo[5]); wq.w = pk2(qo[6], qo[7]);
            wk.x = pk2(ko[0], ko[1]); wk.y = pk2(ko[2], ko[3]); wk.z = pk2(ko[4], ko[5]); wk.w = pk2(ko[6], ko[7]);
            *(LAS u32x4*)(QT + s * 136 + c8) = wq; *(LAS u32x4*)(KT2 + s * 136 + c8) = wk; }
#pragma unroll
        for (int t = 0; t < 2; ++t) { const int i = tid + t * 512, s = i & 63, c8 = (i >> 6) * 8;
#pragma unroll
            for (int j = 0; j < 8; ++j) VT[(c8 + j) * 72 + s] = (bf16_t)bfraw(rv[t], j); }
#pragma unroll
        for (int t = 0; t < 4; ++t) { const int i = tid + t * 512, v = i >> 4, c8 = (i & 15) * 8; *(LAS u32x4*)(SB + v * 136 + c8) = rs[t]; }
        __syncthreads();
        {
            const int mt = wave >> 1, nt0 = (wave & 1) * 2;
            f32x4 pa[2] = {(f32x4){0.f, 0.f, 0.f, 0.f}, (f32x4){0.f, 0.f, 0.f, 0.f}};
#pragma unroll
            for (int ks = 0; ks < 4; ++ks) { const bf16x8 a = *(const LAS bf16x8*)(QT + (mt * 16 + fr) * 136 + ks * 32 + fq * 8);
#pragma unroll
                for (int n2 = 0; n2 < 2; ++n2) { const bf16x8 b = *(const LAS bf16x8*)(KT2 + ((nt0 + n2) * 16 + fr) * 136 + ks * 32 + fq * 8); pa[n2] = __builtin_amdgcn_mfma_f32_16x16x32_bf16(a, b, pa[n2], 0, 0, 0); } }
#pragma unroll
            for (int n2 = 0; n2 < 2; ++n2)
#pragma unroll
                for (int j = 0; j < 4; ++j) { const int t = mt * 16 + fq * 4 + j, s = (nt0 + n2) * 16 + fr; const bool keep = dir == 0 ? (s <= t) : (s >= t); P[t * 72 + s] = (bf16_t)f2bf(keep ? pa[n2][j] : 0.f); }
        }
        __syncthreads();
        {
            f32x4 oa[4];
#pragma unroll
            for (int mi = 0; mi < 4; ++mi) oa[mi] = (f32x4){0.f, 0.f, 0.f, 0.f};
#pragma unroll
            for (int ks = 0; ks < 4; ++ks) { const bf16x8 b = *(const LAS bf16x8*)(SB + (wave * 16 + fr) * 136 + ks * 32 + fq * 8);
#pragma unroll
                for (int mi = 0; mi < 4; ++mi) { const bf16x8 a = *(const LAS bf16x8*)(QT + (mi * 16 + fr) * 136 + ks * 32 + fq * 8); oa[mi] = __builtin_amdgcn_mfma_f32_16x16x32_bf16(b, a, oa[mi], 0, 0, 0); } }
#pragma unroll
            for (int ks = 0; ks < 2; ++ks) { const bf16x8 b = *(const LAS bf16x8*)(VT + (wave * 16 + fr) * 72 + ks * 32 + fq * 8);
#pragma unroll
                for (int mi = 0; mi < 4; ++mi) { const bf16x8 a = *(const LAS bf16x8*)(P + (mi * 16 + fr) * 72 + ks * 32 + fq * 8); oa[mi] = __builtin_amdgcn_mfma_f32_16x16x32_bf16(b, a, oa[mi], 0, 0, 0); } }
            float* Od = dir == 0 ? OF : OB;
#pragma unroll
            for (int mi = 0; mi < 4; ++mi) *(f32x4*)(Od + (size_t)(base + mi * 16 + fr) * 1024 + head * 256 + vh * 128 + wave * 16 + fq * 4) = oa[mi];
        }
        __syncthreads();
    }
}

constexpr int NPHASE = 26;
struct Args { const float* in[21]; float* out; unsigned char* ws; int ph_lo, ph_hi; };
__global__ void __launch_bounds__(512, 2) mk_fwd(Args args) {
    extern __shared__ __attribute__((aligned(16))) unsigned char lds_raw[];
    LAS unsigned char* lds = (LAS unsigned char*)lds_raw;
    volatile LAS unsigned* bst = (volatile LAS unsigned*)(lds + LDS_BYTES - 64);
    if (threadIdx.x < 16) bst[threadIdx.x] = 0u;
    __syncthreads();
    const XcdBarrier gbar = xcd_barrier_post((unsigned*)(args.ws + WS_CTL), bst);
    const int wave_s = __builtin_amdgcn_readfirstlane(threadIdx.x >> 6);
    const int lo = args.ph_lo, hi = args.ph_hi;
#define IN(k) (lo <= (k) && (k) < hi)
#define SEAM(k) do { if (IN(k) && IN((k) + 1)) { cooperative_groups::this_grid().sync(); } } while (0)
#define W13T(l, s) ((bf16_t*)(ws + WS_W13 + (size_t)((l) * 2 + (s)) * W13_BYTES))
#define W2T(l, s) ((bf16_t*)(ws + WS_W2 + (size_t)((l) * 2 + (s)) * W2_BYTES))
#define MODP(l, w) (MOD + (size_t)((l) * 2 + (w)) * NMOD)


    enum { OP_PRO, OP_MOD, OP_NORM, OP_G1, OP_G2, OP_INPROJ, OP_GLA_A, OP_GLA_B, OP_GLA_C, OP_READ, OP_OUTPROJ, OP_QKV, OP_ATTN, OP_COMB, OP_FINAL };
#pragma unroll 1
    for (int p = lo, rep = 0; p < hi; ) {
        (void)rep;
        int lane_l; asm volatile("v_mbcnt_lo_u32_b32 %0, -1, 0\n\tv_mbcnt_hi_u32_b32 %0, -1, %0" : "=v"(lane_l));
        int tid_l = wave_s * 64 + lane_l, bx_l = blockIdx.x, G_l = gridDim.x; asm volatile("" : "+v"(tid_l)); asm volatile("" : "+s"(bx_l)); asm volatile("" : "+s"(G_l));
        const int tid = tid_l, lane = tid & 63, wave = __builtin_amdgcn_readfirstlane(tid >> 6);
        const int G = G_l, bx = bx_l, gw = bx * 8 + wave, NGW = G * 8, gtid = bx * 512 + tid, NT = G * 512;
        const __attribute__((address_space(4))) Args* ap = (const __attribute__((address_space(4))) Args*)__builtin_amdgcn_kernarg_segment_ptr(); asm volatile("" : "+s"(ap));
        unsigned char* ws = ap->ws;
        const float* x = ap->in[0]; const float* cvec = ap->in[1]; const float* ctx = ap->in[2]; const float* cctx = ap->in[3];
        const float* ada_w = ap->in[4]; const float* ada_b = ap->in[5]; const float* ffn_w1 = ap->in[6]; const float* ffn_w3 = ap->in[7]; const float* ffn_w2 = ap->in[8];
        const float* gla_w_in = ap->in[9]; const float* gla_gw2 = ap->in[10]; const float* gla_gb = ap->in[11]; const float* gla_nw = ap->in[12];
        const float* pool_w = ap->in[13]; const float* pool_scale = ap->in[14]; const float* mix0_w_out = ap->in[15]; const float* diff_w_qkv = ap->in[16];
        const float* diff_lambda = ap->in[17]; const float* diff_nw = ap->in[18]; const float* diff_w_out = ap->in[19]; const float* final_nw = ap->in[20];
        float* MOD = (float*)(ws + WS_MOD); float* ADAP = (float*)(ws + WS_ADAP); float* ROPEC = (float*)(ws + WS_ROPEC); float* ROPES = (float*)(ws + WS_ROPES);
        bf16_t* POOLWT = (bf16_t*)(ws + WS_POOLW); float* GLAD = (float*)(ws + WS_GLAD);
        bf16_t* WINT = (bf16_t*)(ws + WS_WIN); bf16_t* WOUT0 = (bf16_t*)(ws + WS_WOUT0); bf16_t* WQKV = (bf16_t*)(ws + WS_WQKV); bf16_t* WOUT1 = (bf16_t*)(ws + WS_WOUT1);
        float* H = (float*)(ws + WS_H); bf16_t* Z = (bf16_t*)(ws + WS_Z); bf16_t* U = (bf16_t*)(ws + WS_U); bf16_t* PROJ = (bf16_t*)(ws + WS_PROJ); bf16_t* A2 = (bf16_t*)(ws + WS_A2);
        bf16_t* POOLED = (bf16_t*)(ws + WS_POOLED); float* LST = (float*)(ws + WS_L); bf16_t* STB = (bf16_t*)(ws + WS_STB); float* OF = (float*)(ws + WS_OF); float* OB = (float*)(ws + WS_OB);
        float* ATT0 = (float*)(ws + WS_ATT0); float* ATT1 = (float*)(ws + WS_ATT1); float* PARTB = (float*)(ws + WS_PART); float* BCUM = (float*)(ws + WS_BCUM);
        int op, layer = 0, slot = 0, half = 0, M = MROWS;
        if (p == 0) op = OP_PRO; else if (p == 1) op = OP_MOD; else if (p == NPHASE - 1) op = OP_FINAL;
        else if (p < 15) { const int q = p - 2;
            op = q == 0 ? OP_NORM : q == 1 ? OP_G1 : q == 2 ? OP_G2 : q == 3 ? OP_NORM : q == 4 ? OP_INPROJ : q == 5 ? OP_GLA_A : q == 6 ? OP_GLA_B : q == 7 ? OP_GLA_C : q == 8 ? OP_READ : q == 9 ? OP_OUTPROJ : q == 10 ? OP_NORM : q == 11 ? OP_G1 : OP_G2;
            slot = q == 3 ? 3 : q == 10 ? 6 : 0; half = q >= 10 ? 1 : 0; }
        else { const int q = p - 15; layer = 1;
            op = q == 0 ? OP_NORM : q == 1 ? OP_G1 : q == 2 ? OP_G2 : q == 3 ? OP_NORM : q == 4 ? OP_QKV : q == 5 ? OP_ATTN : q == 6 ? OP_OUTPROJ : q == 7 ? OP_NORM : q == 8 ? OP_G1 : OP_G2;
            slot = q == 3 ? 3 : q == 7 ? 6 : 0; half = q >= 7 ? 1 : 0; if (q >= 6) M = SEQ; }
        const float* ml = MODP(layer, 0); const float* mc = MODP(layer, 1);

        if (op == OP_PRO) {
            LAS float* SC = (LAS float*)lds;
            for (int i = tid; i < DM; i += 512) { SC[i] = silu_x(cvec[i]); SC[DM + i] = silu_x(cctx[i]); }
            __syncthreads();
            for (int it = gw; it < 2 * ADA_KC * 72; it += NGW) {
                const int l = it / (ADA_KC * 72), r = it % (ADA_KC * 72), kc = r / 72, nb = r % 72, n = nb * 256 + lane * 4;
                const float* w = ada_w + ((size_t)l * DM + kc * 128) * NMOD + n;
                f32x4 a0 = (f32x4){0.f, 0.f, 0.f, 0.f}, a1 = a0;
#pragma unroll 8
                for (int k = 0; k < 128; ++k) { const f32x4 wv = *(const f32x4*)(w + (size_t)k * NMOD); a0 = a0 + wv * SC[kc * 128 + k]; a1 = a1 + wv * SC[DM + kc * 128 + k]; }
                *(f32x4*)(ADAP + ((size_t)(l * ADA_KC + kc) * 2 + 0) * NMOD + n) = a0;
                *(f32x4*)(ADAP + ((size_t)(l * ADA_KC + kc) * 2 + 1) * NMOD + n) = a1;
            }
            LAS float* scr = (LAS float*)(lds + 16384 + wave * 8704);
            constexpr int I_F13 = (DM / 64) * (DFF / 32), I_F2 = (DFF / 64) * (DM / 32), I_IN = (DM / 64) * (IN0 / 32), I_O = (DM / 64) * (DM / 32), I_QKV = (DM / 64) * (QKVN / 32), I_PW = (256 / 64) * (256 / 32);
            constexpr int NIT = 4 * (2 * I_F13 + I_F2) + I_IN + 2 * I_O + I_QKV + 4 * I_PW;
            const bool bal = (NGW == 2048), heavy = bal && gw < 256;
            const int k0 = heavy ? 10 : 0, n_own = (NIT - gw + NGW - 1) / NGW - k0;
            const int n_extra = (bal && !heavy) ? (2560 - (gw - 256) + 1791) / 1792 : 0;
#pragma unroll 1
            for (int v = 0; v < n_own + n_extra; ++v) {
                int it;
                if (v < n_own) it = gw + (k0 + v) * NGW; else { const int j = (gw - 256) + (v - n_own) * 1792; it = (j & 255) + (j >> 8) * NGW; }
                int r = it;
                if (r < 4 * (2 * I_F13 + I_F2)) { const int ls = r / (2 * I_F13 + I_F2); r -= ls * (2 * I_F13 + I_F2);
                    if (r < I_F13) { transpose_item<1>(ffn_w1 + (size_t)ls * DM * DFF, DM, DFF, W13T(0, 0) + (size_t)ls * (W13_BYTES / 2), 0, scr, r, lane); continue; } r -= I_F13;
                    if (r < I_F13) { transpose_item<1>(ffn_w3 + (size_t)ls * DM * DFF, DM, DFF, W13T(0, 0) + (size_t)ls * (W13_BYTES / 2), 1, scr, r, lane); continue; } r -= I_F13;
                    transpose_item<0>(ffn_w2 + (size_t)ls * DFF * DM, DFF, DM, W2T(0, 0) + (size_t)ls * (W2_BYTES / 2), 0, scr, r, lane); continue; }
                r -= 4 * (2 * I_F13 + I_F2);
                if (r < I_IN) { transpose_item<0>(gla_w_in, DM, IN0, WINT, 0, scr, r, lane); continue; } r -= I_IN;
                if (r < I_O) { transpose_item<0>(mix0_w_out, DM, DM, WOUT0, 0, scr, r, lane); continue; } r -= I_O;
                if (r < I_O) { transpose_item<0>(diff_w_out, DM, DM, WOUT1, 0, scr, r, lane); continue; } r -= I_O;
                if (r < I_QKV) { transpose_item<2>(diff_w_qkv, DM, QKVN, WQKV, 0, scr, r, lane); continue; } r -= I_QKV;
                { const int g = r / I_PW; transpose_item<0>(pool_w + (size_t)g * 65536, 256, 256, POOLWT + (size_t)g * 65536, 0, scr, r % I_PW, lane); }
            }
            for (int i = gtid; i < (IN0P - IN0) * DM / 8; i += NT) ((u32x4*)(WINT + (size_t)IN0 * DM))[i] = (u32x4){0u, 0u, 0u, 0u};
            for (int i = gtid; i < SEQ * 64; i += NT) { const int t = i >> 6, j = i & 63; const int pos = j < 32 ? (t >> 6) : (t & 63);
                const float ang = (float)pos * exp2f(-(float)(j & 31) * (13.287712379549449f / 32.0f)); ROPEC[i] = __cosf(ang); ROPES[i] = __sinf(ang); }
            __syncthreads();
        } else if (op == OP_MOD) {
            for (int i = gtid; i < 2 * 2 * NMOD; i += NT) { const int l = i / (2 * NMOD), r = i % (2 * NMOD), w = r / NMOD, n = r % NMOD;
                float a = ada_b[l * NMOD + n];
                for (int kc = 0; kc < ADA_KC; ++kc) a += ADAP[((size_t)(l * ADA_KC + kc) * 2 + w) * NMOD + n];
                MOD[i] = a; }
        } else if (op == OP_NORM) {
            const bool first = (p == 2);
            const bool lazy = (G == 256);
            norm_mod_phase(first ? x : H, (first || (lazy && p == 5)) ? ctx : H + (size_t)SEQ * DM, (const bf16_t*)nullptr, H, first && !lazy, first && !lazy, PARTB, (first || G != 256) ? 0 : (slot == 6 ? 4 : 11), Z, ml, mc, slot, M, gw, NGW, lane, lds, bx, G, wave);
        } else if (op == OP_G1) {
            pg8::Gemm g{Z, W13T(layer, half), M, 2 * DFF, DM}; pg8::StaticOrder S; S.init(M, 2 * DFF, G, bx, DM); pg8::EpiSwiglu E{U, DFF};
            pg8::gemm_phase<pg8::EpiSwiglu, pg8::StaticOrder, true, true>(lds, g, S, E, tid);
        } else if (op == OP_G2 || op == OP_OUTPROJ) {
            const bool ffn = op == OP_G2;
            const bf16_t* Ap = ffn ? U : A2; const bf16_t* Bp = ffn ? W2T(layer, half) : (layer == 0 ? WOUT0 : WOUT1);
            const int K = ffn ? DFF : DM, gs = ffn ? (half ? 8 : 2) : 5;
            pg8::Gemm g{Ap, Bp, M, DM, K}; pg8::ResidOrder S; S.init(M, DM, K, G, bx); float cf = ffn ? 0.5f : 1.0f;
#ifdef PROBE_MASK
            if (((PROBE_MASK >> op) & 1) && rep == 0) cf = 0.f;
#endif
            pg8::EpiResid E{H, (G == 256 && p == 4) ? x : (const float*)H, ml + gs * DM, mc + gs * DM, cf, DM, S.split, PARTB};
            pg8::gemm_phase<pg8::EpiResid, pg8::ResidOrder, true, true>(lds, g, S, E, tid);
        } else if (op == OP_INPROJ || op == OP_GLA_B) {
            if (op == OP_GLA_B) gla_phase_b(LST, GLAD, STB, gtid, NT);
            {
                const bool ip = op == OP_INPROJ;
                pg8::Gemm g{ip ? Z : POOLED, ip ? WINT : POOLWT, ip ? MROWS : 4 * MROWS, ip ? IN0P : 256, ip ? DM : 256};
                pg8::StaticOrder S; S.init(ip ? MROWS : 4 * MROWS, ip ? IN0P : 256, G, bx, ip ? DM : 256, ip ? 0 : 33);
                pg8::EpiStore E{ip ? PROJ : A2 + 1024, ip ? IN0P : DM, ip ? (const float*)nullptr : pool_scale, ip ? 0 : 33};
                pg8::gemm_phase<pg8::EpiStore, pg8::StaticOrder, true, true>(lds, g, S, E, tid);
            }
        } else if (op == OP_GLA_A) {
            gla_phase_a(lds, PROJ, gla_gw2, gla_gb, LST, GLAD, BCUM, bx, G, tid);
            if (G == 256) { if (bx >= 32) pool_phase(PROJ, POOLED, (bx - 32) * 512 + tid, (G - 32) * 512); } else pool_phase(PROJ, POOLED, gtid, NT);
        } else if (op == OP_GLA_C) {
            gla_phase_c(lds, PROJ, BCUM, STB, OF, OB, bx, G, tid);
        } else if (op == OP_READ) {
            gla_readout_phase(OF, OB, PROJ, gla_nw, A2, gw, NGW, lane);
        } else if (op == OP_QKV) {
            pg8::Gemm g{Z, WQKV, MROWS, QKVN, DM}; pg8::StaticOrder S; S.init(MROWS, QKVN, G, bx, DM); pg8::EpiQkv E{PROJ, QKVN, ROPEC, ROPES};
            pg8::gemm_phase<pg8::EpiQkv, pg8::StaticOrder, true, true>(lds, g, S, E, tid);
        } else if (op == OP_ATTN) {
            const float lam_init = 0.8f - 0.6f * 0.74081822068171786607f;
            const float* lp = diff_lambda;
            const float s01 = wave_sum(lp[lane] * lp[128 + lane] + lp[64 + lane] * lp[192 + lane]);
            const float s23 = wave_sum(lp[256 + lane] * lp[384 + lane] + lp[320 + lane] * lp[448 + lane]);
            const float lam = expf(s01) - expf(s23) + lam_init;
#pragma unroll 1
            for (int un = bx; un < 256; un += G) {
                const int h = un & 7, qb = un >> 3;
#pragma unroll 1
                for (int c = 0; c < 2; ++c) {
                    const att::bf16* Qp = (const att::bf16*)PROJ + (size_t)(qb * 256) * QKVN + h * 256 + c * 128;
                    const att::bf16* Kp = (const att::bf16*)PROJ + DM + h * 256 + c * 128;
                    const att::bf16* Vp = (const att::bf16*)PROJ + 2 * DM + h * 256;
                    float* Op = ATT0 + (size_t)(qb * 256) * DM + h * 256;
                    att::attn_dv256_body(Qp, Kp, Vp, Op, MROWS, (char*)lds_raw, lds, tid, c, lam, 1.0f - lam_init, diff_nw, A2 + (size_t)(qb * 256) * DM + h * 256);
                    __syncthreads();
                }
            }
        } else if (op == OP_COMB) {
            diff_combine_phase(ATT0, ATT1, diff_lambda, diff_nw, A2, gw, NGW, lane);
        } else {
            final_norm_phase(H, (const bf16_t*)nullptr, ap->out, final_nw, gw, NGW, lane);
        }
#ifdef PROBE_MASK
        if (rep == 0 && ((PROBE_MASK >> op) & 1)) { rep = 1; xcd_barrier(gbar); continue; }
        rep = 0;
#endif
        ++p;
        if (p < hi) { if (p == 1) cooperative_groups::this_grid().sync(); else xcd_barrier(gbar); }
    }
#undef IN
#undef SEAM
}

extern "C" void kernel_launch(void* const* d_in, const int* in_sizes, int n_in, void* d_out, int out_size, void* d_ws, size_t ws_size, hipStream_t stream) {
    static int grid = 0;
    if (grid == 0) {
        if (n_in != 21 || out_size != SEQ * DM || ws_size < WS_END) { fprintf(stderr, "kernel_launch: unexpected shapes: n_in %d out %d ws %zu (need %zu)\n", n_in, out_size, ws_size, (size_t)WS_END); grid = -1; return; }
        int dev = 0, cus = 0, per_cu = 0;
        if (hipGetDevice(&dev) != hipSuccess || hipDeviceGetAttribute(&cus, hipDeviceAttributeMultiprocessorCount, dev) != hipSuccess) { grid = -1; return; }
        if (hipFuncSetAttribute((const void*)mk_fwd, hipFuncAttributeMaxDynamicSharedMemorySize, LDS_BYTES) != hipSuccess) { fprintf(stderr, "kernel_launch: hipFuncSetAttribute failed\n"); grid = -1; return; }
        if (hipOccupancyMaxActiveBlocksPerMultiprocessor(&per_cu, (const void*)mk_fwd, 512, LDS_BYTES) != hipSuccess || per_cu < 1) { fprintf(stderr, "kernel_launch: occupancy query gave %d\n", per_cu); per_cu = 1; }
        (void)hipGetLastError();
        grid = cus * 1;
    }
    if (grid < 0) return;
    if (hipMemsetAsync((char*)d_ws + WS_CTL, 0, CTL_ZERO_BYTES, stream) != hipSuccess) { fprintf(stderr, "kernel_launch: memset of the barrier words failed\n"); return; }
    Args a{};
    for (int i = 0; i < 21; ++i) a.in[i] = (const float*)d_in[i];
    a.out = (float*)d_out; a.ws = (unsigned char*)d_ws;
#if MK_SPLIT
    for (int p = 0; p < NPHASE; ++p) { a.ph_lo = p; a.ph_hi = p + 1; hipLaunchKernelGGL(mk_fwd, dim3(grid), dim3(512), LDS_BYTES, stream, a); }
#else
    a.ph_lo = 0; a.ph_hi = NPHASE;
    void* kargs[] = {&a};
    hipError_t e = hipLaunchCooperativeKernel((const void*)mk_fwd, dim3(grid), dim3(512), kargs, LDS_BYTES, stream);
    if (e != hipSuccess) fprintf(stderr, "kernel_launch: cooperative launch failed: %s (grid %d)\n", hipGetErrorString(e), grid);
#endif
    const hipError_t le = hipPeekAtLastError();
    if (le != hipSuccess) fprintf(stderr, "kernel_launch: launch error %s\n", hipGetErrorName(le));
}
```
